# Optimizing an MI355X kernel written in HIP

```python
import jax, jax.numpy as jnp
from jax import lax
import numpy as np

D_MODEL = 1024
BATCH = 16
SEQ = 2048
DEPTH = 1

HEAD_DIM = 64
ATTN_WIDTH = D_MODEL // 2
CONV_WIDTH = D_MODEL - ATTN_WIDTH
N_Q_HEADS = ATTN_WIDTH // HEAD_DIM
N_KV_HEADS = 2
GQA_GROUP = N_Q_HEADS // N_KV_HEADS
KV_WIDTH = N_KV_HEADS * HEAD_DIM
WINDOW = 128
BLOCK = 128
ROT_DIM = HEAD_DIM // 4
ROPE_THETA = 500000.0
CONV_W = 3
D_FF = 2816
N_MOD = 9
LN_EPS = 1e-5
DN_ALPHA = (2.0 * DEPTH) ** 0.25
DN_BETA = (8.0 * DEPTH) ** -0.25
IN_WIDTH = ATTN_WIDTH + 2 * KV_WIDTH + 3 * CONV_WIDTH

kernel_name = "hybrid_swa_sink_shortconv_macaron_deepnorm_adaln"


def layer_norm(x, g, b):
    xf = x.astype(jnp.float32)
    mu = jnp.mean(xf, axis=-1, keepdims=True)
    var = jnp.mean(jnp.square(xf - mu), axis=-1, keepdims=True)
    y = (xf - mu) * lax.rsqrt(var + LN_EPS) * g.astype(jnp.float32) + b.astype(jnp.float32)
    return y.astype(x.dtype)


def swiglu(h, w_gate_up, w_down):
    gu = h @ w_gate_up
    g, u = jnp.split(gu, 2, axis=-1)
    return (jax.nn.silu(g) * u) @ w_down


def partial_rope(x, positions):
    half = ROT_DIM // 2
    inv_freq = jnp.power(jnp.float32(ROPE_THETA), -jnp.arange(0, ROT_DIM, 2, dtype=jnp.float32) / ROT_DIM)
    ang = positions.astype(jnp.float32)[..., None] * inv_freq
    cos = jnp.cos(ang)[:, :, None, :].astype(x.dtype)
    sin = jnp.sin(ang)[:, :, None, :].astype(x.dtype)
    x1 = x[..., :half]
    x2 = x[..., half:ROT_DIM]
    rest = x[..., ROT_DIM:]
    return jnp.concatenate([x1 * cos - x2 * sin, x2 * cos + x1 * sin, rest], axis=-1)


def sliding_window_sink_attention(q, k, v, sinks):
    bsz, seq = q.shape[0], q.shape[1]
    nb = seq // BLOCK
    qb = q.reshape(bsz, nb, BLOCK, N_KV_HEADS, GQA_GROUP, HEAD_DIM)
    pad = ((0, 0), (BLOCK, 0), (0, 0), (0, 0))
    kp = jnp.pad(k, pad).reshape(bsz, nb + 1, BLOCK, N_KV_HEADS, HEAD_DIM)
    vp = jnp.pad(v, pad).reshape(bsz, nb + 1, BLOCK, N_KV_HEADS, HEAD_DIM)
    kb = jnp.concatenate([kp[:, :-1], kp[:, 1:]], axis=2)
    vb = jnp.concatenate([vp[:, :-1], vp[:, 1:]], axis=2)
    scale = HEAD_DIM ** -0.5
    scores = jnp.einsum('bnqhgd,bnkhd->bnhgqk', qb, kb).astype(jnp.float32) * scale
    blk = jnp.arange(nb)[:, None, None]
    qi = jnp.arange(BLOCK)[None, :, None]
    ki = jnp.arange(2 * BLOCK)[None, None, :]
    diff = qi + BLOCK - ki
    key_pos = (blk - 1) * BLOCK + ki
    valid = (diff >= 0) & (diff < WINDOW) & (key_pos >= 0)
    scores = jnp.where(valid[None, :, None, None], scores, -jnp.inf)
    sink = jnp.broadcast_to(
        sinks.astype(jnp.float32).reshape(N_KV_HEADS, GQA_GROUP)[None, None, :, :, None, None],
        scores.shape[:-1] + (1,))
    probs = jax.nn.softmax(jnp.concatenate([scores, sink], axis=-1), axis=-1)[..., :-1]
    out = jnp.einsum('bnhgqk,bnkhd->bnqhgd', probs.astype(v.dtype), vb)
    return out.reshape(bsz, seq, N_Q_HEADS * HEAD_DIM)


def short_gated_conv(u, b_gate, c_gate, conv_w):
    seq = u.shape[1]
    z = c_gate * u
    zp = jnp.pad(z, ((0, 0), (CONV_W - 1, 0), (0, 0)))
    y = conv_w[0] * zp[:, 0:seq]
    for tap in range(1, CONV_W):
        y = y + conv_w[tap] * zp[:, tap:tap + seq]
    return b_gate * y


def setup_inputs(seed: int = 0) -> dict:
    key = jax.random.key(seed)
    ks = jax.random.split(key, 20)
    nrm = lambda k, shape, s: jax.random.normal(k, shape, jnp.float32) * s
    L, D = DEPTH, D_MODEL
    x = jax.random.normal(ks[0], (BATCH, SEQ, D), jnp.float32)
    c = jax.random.normal(ks[1], (BATCH, D), jnp.float32)
    offsets = jax.random.randint(ks[2], (BATCH, 1), 0, 1024, dtype=jnp.int32)
    positions = offsets + jnp.arange(SEQ, dtype=jnp.int32)[None, :]
    return {
        "x": x,
        "c": c,
        "positions": positions,
        "w_ada": nrm(ks[3], (L, D, N_MOD * D), 0.1 * D ** -0.5),
        "b_ada": nrm(ks[4], (L, N_MOD * D), 0.01),
        "ffn1_w_gate_up": nrm(ks[5], (L, D, 2 * D_FF), D ** -0.5),
        "ffn1_w_down": nrm(ks[6], (L, D_FF, D), DN_BETA * D_FF ** -0.5),
        "ln1_g": 1.0 + nrm(ks[7], (L, D), 0.02),
        "ln1_b": nrm(ks[8], (L, D), 0.02),
        "w_in": nrm(ks[9], (L, D, IN_WIDTH), D ** -0.5),
        "conv_w": nrm(ks[10], (L, CONV_W, CONV_WIDTH), CONV_W ** -0.5),
        "attn_sinks": nrm(ks[11], (L, N_Q_HEADS), 1.0),
        "w_out": nrm(ks[12], (L, D, D), DN_BETA * D ** -0.5),
        "ln2_g": 1.0 + nrm(ks[13], (L, D), 0.02),
        "ln2_b": nrm(ks[14], (L, D), 0.02),
        "ffn2_w_gate_up": nrm(ks[15], (L, D, 2 * D_FF), D ** -0.5),
        "ffn2_w_down": nrm(ks[16], (L, D_FF, D), DN_BETA * D_FF ** -0.5),
        "ln3_g": 1.0 + nrm(ks[17], (L, D), 0.02),
        "ln3_b": nrm(ks[18], (L, D), 0.02),
    }


def reference(x, c, positions, w_ada, b_ada, ffn1_w_gate_up, ffn1_w_down, ln1_g, ln1_b,
              w_in, conv_w, attn_sinks, w_out, ln2_g, ln2_b,
              ffn2_w_gate_up, ffn2_w_down, ln3_g, ln3_b):
    bsz, seq = x.shape[0], x.shape[1]
    split_at = [ATTN_WIDTH, ATTN_WIDTH + KV_WIDTH, ATTN_WIDTH + 2 * KV_WIDTH,
                ATTN_WIDTH + 2 * KV_WIDTH + CONV_WIDTH, ATTN_WIDTH + 2 * KV_WIDTH + 2 * CONV_WIDTH]
    cond = jax.nn.silu(c)
    for l in range(DEPTH):
        mod = (cond @ w_ada[l] + b_ada[l])[:, None, :]
        sh1, sc1, g1, sh2, sc2, g2, sh3, sc3, g3 = jnp.split(mod, N_MOD, axis=-1)

        h = x * (1 + sc1) + sh1
        x = layer_norm(DN_ALPHA * x + 0.5 * (1 + g1) * swiglu(h, ffn1_w_gate_up[l], ffn1_w_down[l]),
                       ln1_g[l], ln1_b[l])

        h = x * (1 + sc2) + sh2
        proj = h @ w_in[l]
        q, k, v, u, b_gate, c_gate = jnp.split(proj, split_at, axis=-1)
        q = partial_rope(q.reshape(bsz, seq, N_Q_HEADS, HEAD_DIM), positions)
        k = partial_rope(k.reshape(bsz, seq, N_KV_HEADS, HEAD_DIM), positions)
        v = v.reshape(bsz, seq, N_KV_HEADS, HEAD_DIM)
        attn_out = sliding_window_sink_attention(q, k, v, attn_sinks[l])
        conv_out = short_gated_conv(u, b_gate, c_gate, conv_w[l])
        mix = jnp.concatenate([attn_out, conv_out], axis=-1) @ w_out[l]
        x = layer_norm(DN_ALPHA * x + (1 + g2) * mix, ln2_g[l], ln2_b[l])

        h = x * (1 + sc3) + sh3
        x = layer_norm(DN_ALPHA * x + 0.5 * (1 + g3) * swiglu(h, ffn2_w_gate_up[l], ffn2_w_down[l]),
                       ln3_g[l], ln3_b[l])
    return x
```

```cpp
#include <hip/hip_runtime.h>
#include <hip/hip_cooperative_groups.h>
#include <cstdio>
#include <cstdint>
namespace cg = cooperative_groups;

#ifndef MK_SPLIT
#define MK_SPLIT 0
#endif

namespace pg8 {
#define PG8_LAS __attribute__((address_space(3)))
typedef unsigned short bf16_t;
typedef short bf16x8 __attribute__((ext_vector_type(8)));
typedef float f32x4 __attribute__((ext_vector_type(4)));
typedef unsigned u32x4 __attribute__((ext_vector_type(4)));
constexpr int BM = 256, BK = 64, HALF = 128, HTB = HALF * BK * 2  , STAGE_BYTES = 8 * HTB, NXCD = 8, WGM = 8;

__host__ __device__ __forceinline__ int lds_byte(int r, int c) { const int st = (r >> 4) * 2 + (c >> 5), rr = r & 15, cc = c & 31, ob = rr * 64 + cc * 2; return st * 1024 + (ob ^ (((ob >> 9) & 1) << 5)); }
__host__ __device__ __forceinline__ void stage_rc(int b, int& R, int& C) { const int st = b / 1024, sb = b % 1024, swz = sb ^ (((sb >> 9) & 1) << 5); R = (st >> 1) * 16 + swz / 64; C = (st & 1) * 32 + (swz % 64) / 2; }
__host__ __device__ __forceinline__ int perm32(int rho) { const int n = rho >> 4, i = rho & 15; return 8 * (i >> 2) + 4 * n + (i & 3); }

struct Unit { int pm, pn; };
struct Gemm { const bf16_t* A; const bf16_t* Bt; int M, N, K; };

struct StaticOrder {
    int nM, nN, nwg, G, c;
    __host__ __device__ void init(int M, int N, int G_, int c_) { nM = M / BM; nN = N / BM; nwg = nM * nN; G = G_; c = c_; }
    __host__ __device__ bool next(int i, Unit& u) const {
        const long L = (long)i * G + c; if (L >= nwg) return false;
        int wgid = (int)L; { const int q = nwg / NXCD, r = nwg % NXCD, xcd = wgid % NXCD, off = wgid / NXCD; wgid = (xcd < r ? xcd * (q + 1) : r * (q + 1) + (xcd - r) * q) + off; }
        const int nig = WGM * nN, gid = wgid / nig, fm = gid * WGM, gsz = (nM - fm) < WGM ? (nM - fm) : WGM;
        u.pm = fm + ((wgid % nig) % gsz); u.pn = (wgid % nig) / gsz; return true;
    }
    __device__ __forceinline__ void a_ready(const Unit&) const {}
    __device__ __forceinline__ void done(const Unit&) const {}
};

constexpr int P_D = 1024, P_FF = 2816, P_NIN = 2304, P_NMOD = 9216, P_SEQ = 2048;
__device__ __forceinline__ unsigned cvt_pk_bf16(float lo, float hi) { unsigned r; asm volatile("v_cvt_pk_bf16_f32 %0, %1, %2" : "=v"(r) : "v"(lo), "v"(hi)); return r; }
__device__ __forceinline__ float silu_f(float g) { return g * __builtin_amdgcn_rcpf(1.0f + __expf(-g)); }

struct EpiSwiGLU {
    static constexpr bool PERM = true, AFTER_DRAIN = false;
    bf16_t* O;
    __device__ __forceinline__ void operator()(const f32x4 (&acc)[2][2][4][2], const Unit& u, int wr, int wc, int fr, int fq) const {
        const int row0 = u.pm * BM + wr * 64 + fr; const int col0 = u.pn * HALF + wc * 32 + 8 * fq;
#pragma unroll
        for (int ai = 0; ai < 2; ++ai)
#pragma unroll
            for (int m = 0; m < 4; ++m) {
                bf16_t* rowp = O + (size_t)(row0 + ai * HALF + m * 16) * P_FF + col0;
                const f32x4 g0 = acc[ai][0][m][0], g1 = acc[ai][0][m][1], u0 = acc[ai][1][m][0], u1 = acc[ai][1][m][1];
                u32x4 w;
                w.x = cvt_pk_bf16(silu_f(g0[0]) * u0[0], silu_f(g0[1]) * u0[1]);
                w.y = cvt_pk_bf16(silu_f(g0[2]) * u0[2], silu_f(g0[3]) * u0[3]);
                w.z = cvt_pk_bf16(silu_f(g1[0]) * u1[0], silu_f(g1[1]) * u1[1]);
                w.w = cvt_pk_bf16(silu_f(g1[2]) * u1[2], silu_f(g1[3]) * u1[3]);
                *(u32x4*)rowp = w;
            }
    }
};

struct EpiResid {
    static constexpr bool PERM = false, AFTER_DRAIN = false;
    const float* xres; float* y; const float* gate; float coef; float alpha;
    __device__ __forceinline__ void operator()(const f32x4 (&acc)[2][2][4][2], const Unit& u, int wr, int wc, int fr, int fq) const {
        const int row0 = u.pm * BM + wr * 64 + fr; const int col0 = u.pn * BM + wc * 32 + 4 * fq;
        const float* gp = gate + (size_t)(u.pm >> 3) * P_NMOD + col0;
        f32x4 gv[2][2];
#pragma unroll
        for (int bj = 0; bj < 2; ++bj)
#pragma unroll
            for (int n = 0; n < 2; ++n) { const f32x4 t = *(const f32x4*)(gp + bj * HALF + n * 16); gv[bj][n] = (t + 1.0f) * coef; }
#pragma unroll
        for (int ai = 0; ai < 2; ++ai)
#pragma unroll
            for (int m = 0; m < 4; ++m) {
                const size_t off = (size_t)(row0 + ai * HALF + m * 16) * P_D + col0;
#pragma unroll
                for (int bj = 0; bj < 2; ++bj)
#pragma unroll
                    for (int n = 0; n < 2; ++n) {
                        const f32x4 xv = *(const f32x4*)(xres + off + bj * HALF + n * 16);
                        *(f32x4*)(y + off + bj * HALF + n * 16) = xv * alpha + gv[bj][n] * acc[ai][bj][m][n];
                    }
            }
    }
};

struct EpiProj {
    static constexpr bool PERM = true, AFTER_DRAIN = false;
    bf16_t* P; bf16_t* Vt; const float* tab;
    __device__ __forceinline__ void operator()(const f32x4 (&acc)[2][2][4][2], const Unit& u, int wr, int wc, int fr, int fq) const {
        const int row0 = u.pm * BM + wr * 64 + fr;
#pragma unroll
        for (int bj = 0; bj < 2; ++bj) {
            const int tilecol = u.pn * BM + bj * HALF;
            const int cb = tilecol + wc * 32 + 8 * fq;
            const bool is_v = (tilecol == 640);
            const bool rope = (tilecol < 640) && ((wc & 1) == 0);
#pragma unroll
            for (int ai = 0; ai < 2; ++ai)
#pragma unroll
                for (int m = 0; m < 4; ++m) {
                    const int row = row0 + ai * HALF + m * 16;
                    f32x4 v0 = acc[ai][bj][m][0], v1 = acc[ai][bj][m][1];
                    if (rope) {
                        f32x4 p0, p1;
#pragma unroll
                        for (int j = 0; j < 4; ++j) { p0[j] = __shfl_xor(v0[j], 16); p1[j] = __shfl_xor(v1[j], 16); }
                        if (fq < 2) {
                            const float* tp = tab + (size_t)row * 16;
                            const f32x4 c0 = *(const f32x4*)(tp), c1 = *(const f32x4*)(tp + 4), s0 = *(const f32x4*)(tp + 8), s1 = *(const f32x4*)(tp + 12);
                            const float sg = (fq == 0) ? -1.0f : 1.0f;
                            v0 = v0 * c0 + (p0 * s0) * sg; v1 = v1 * c1 + (p1 * s1) * sg;
                        }
                    }
                    if (is_v) {
                        const int b = row >> 11, s = row & (P_SEQ - 1);
                        const int colv = wc * 32 + 8 * fq;
                        bf16_t* vp = Vt + ((size_t)(b * 2 + (colv >> 6)) * 64 + (colv & 63)) * P_SEQ + s;
                        const unsigned w0 = cvt_pk_bf16(v0[0], v0[1]), w1 = cvt_pk_bf16(v0[2], v0[3]), w2 = cvt_pk_bf16(v1[0], v1[1]), w3 = cvt_pk_bf16(v1[2], v1[3]);
                        vp[0 * P_SEQ] = (bf16_t)(w0 & 0xffffu); vp[1 * P_SEQ] = (bf16_t)(w0 >> 16);
                        vp[2 * P_SEQ] = (bf16_t)(w1 & 0xffffu); vp[3 * P_SEQ] = (bf16_t)(w1 >> 16);
                        vp[4 * P_SEQ] = (bf16_t)(w2 & 0xffffu); vp[5 * P_SEQ] = (bf16_t)(w2 >> 16);
                        vp[6 * P_SEQ] = (bf16_t)(w3 & 0xffffu); vp[7 * P_SEQ] = (bf16_t)(w3 >> 16);
                    } else {
                        u32x4 w; w.x = cvt_pk_bf16(v0[0], v0[1]); w.y = cvt_pk_bf16(v0[2], v0[3]); w.z = cvt_pk_bf16(v1[0], v1[1]); w.w = cvt_pk_bf16(v1[2], v1[3]);
                        *(u32x4*)(P + (size_t)row * P_NIN + cb) = w;
                    }
                }
        }
    }
};

template <class Epi, class Sched, bool ALIGN_EPI = false, bool SP2 = false>
__device__ __forceinline__ void gemm_phase(PG8_LAS unsigned char* lds, const Gemm g, const Sched& S, const Epi& E) {
    const int tid = threadIdx.x, wid = __builtin_amdgcn_readfirstlane(tid >> 6), lane = tid & 63, wr = wid >> 2, wc = wid & 3, fr = lane & 15, fq = lane >> 4;
    const int K = g.K, nt = K / BK;
    unsigned voffA[2], voffB[2];
#pragma unroll
    for (int i = 0; i < 2; ++i) { int R, C; stage_rc(tid * 16 + i * 8192, R, C); const int Rb = Epi::PERM ? ((R & ~31) + perm32(R & 31)) : R;
        voffA[i] = (unsigned)(R * K + C) * 2u; voffB[i] = (unsigned)(Rb * K + C) * 2u; }
    const size_t kstep = (size_t)(BK * 2);
    const size_t hstep = (size_t)HALF * K * 2;
    const size_t tstep = 2 * hstep;
    const unsigned ldsw = (unsigned)wid * 1024u;
    const int aoff = lds_byte(wr * 64 + fr, fq * 8), boff = lds_byte(wc * 32 + fr, fq * 8);
#define PG8_SA(b, h) (((b) * 2 + (h)) * HTB)
#define PG8_SB(b, h) ((4 + (b) * 2 + (h)) * HTB)
#define PG8_STAGE(bufoff, gbase, voff) do { _Pragma("unroll") for (int _i = 0; _i < 2; ++_i) \
        __builtin_amdgcn_global_load_lds((const unsigned*)((const char*)(gbase) + (voff)[_i]), (PG8_LAS unsigned*)(lds + (bufoff) + ldsw + _i * 8192), 16, 0, 0); } while (0)
#define PG8_LDA(dst, b, h) do { _Pragma("unroll") for (int m = 0; m < 4; ++m) _Pragma("unroll") for (int k = 0; k < 2; ++k) dst[m][k] = *(const PG8_LAS bf16x8*)(lds + PG8_SA(b, h) + aoff + m * 2048 + k * 1024); } while (0)
#define PG8_LDB(dst, b, h) do { _Pragma("unroll") for (int n = 0; n < 2; ++n) _Pragma("unroll") for (int k = 0; k < 2; ++k) dst[n][k] = *(const PG8_LAS bf16x8*)(lds + PG8_SB(b, h) + boff + n * 2048 + k * 1024); } while (0)
#define PG8_MMA(ai, bj, At, Bt) do { __builtin_amdgcn_s_setprio(1); _Pragma("unroll") for (int m = 0; m < 4; ++m) _Pragma("unroll") for (int n = 0; n < 2; ++n) _Pragma("unroll") for (int k = 0; k < 2; ++k) \
        acc[ai][bj][m][n] = __builtin_amdgcn_mfma_f32_16x16x32_bf16(Bt[n][k], At[m][k], acc[ai][bj][m][n], 0, 0, 0); __builtin_amdgcn_s_setprio(0); } while (0)
#define PG8_WAIT_V(n) asm volatile("s_waitcnt vmcnt(" #n ")" ::: "memory")
#define PG8_WAIT_L(n) asm volatile("s_waitcnt lgkmcnt(" #n ")" ::: "memory")
#define PG8_BAR __builtin_amdgcn_s_barrier()
#define PG8_SCHED __builtin_amdgcn_sched_barrier(0)
    Unit cur, nxt; int ui = 0;
    if (!S.next(0, cur)) return;
    f32x4 acc[2][2][4][2];
#pragma unroll
    for (int a = 0; a < 2; ++a)
#pragma unroll
        for (int b = 0; b < 2; ++b)
#pragma unroll
            for (int m = 0; m < 4; ++m)
#pragma unroll
                for (int n = 0; n < 2; ++n) acc[a][b][m][n] = (f32x4){0.f, 0.f, 0.f, 0.f};
    bf16x8 At[4][2], B0[2][2], B1[2][2];
    const char* cA = (const char*)g.A + (size_t)cur.pm * tstep; const char* cB = (const char*)g.Bt + (size_t)cur.pn * tstep;
    S.a_ready(cur);
    if constexpr (SP2) {
        PG8_STAGE(PG8_SB(0, 0), cB, voffB); PG8_STAGE(PG8_SB(0, 1), cB + hstep, voffB); PG8_STAGE(PG8_SA(0, 0), cA, voffA); PG8_STAGE(PG8_SA(0, 1), cA + hstep, voffA);
        if (wr == 1) PG8_BAR;
        PG8_WAIT_V(2); PG8_BAR;
        PG8_STAGE(PG8_SB(1, 0), cB + kstep, voffB); PG8_STAGE(PG8_SA(1, 0), cA + kstep, voffA); PG8_STAGE(PG8_SB(1, 1), cB + hstep + kstep, voffB);
        PG8_WAIT_V(6); PG8_BAR;
    } else {
        PG8_STAGE(PG8_SB(0, 0), cB, voffB); PG8_STAGE(PG8_SA(0, 0), cA, voffA); PG8_STAGE(PG8_SB(0, 1), cB + hstep, voffB); PG8_STAGE(PG8_SA(0, 1), cA + hstep, voffA);
        if (wr == 1) PG8_BAR;
        PG8_WAIT_V(4); PG8_BAR;
        PG8_STAGE(PG8_SB(1, 0), cB + kstep, voffB); PG8_STAGE(PG8_SA(1, 0), cA + kstep, voffA); PG8_STAGE(PG8_SB(1, 1), cB + hstep + kstep, voffB);
        PG8_WAIT_V(6); PG8_BAR;
    }
    for (;;) {
        const bool has_next = S.next(ui + 1, nxt);
        const char* nA = has_next ? (const char*)g.A + (size_t)nxt.pm * tstep : cA; const char* nB = has_next ? (const char*)g.Bt + (size_t)nxt.pn * tstep : cB;
        for (int t = 0; t < nt; t += 2) {
            const bool last = (t == nt - 2);
            const char* a1 = cA + (size_t)(t + 1) * kstep;
            const char* a2 = last ? nA : cA + (size_t)(t + 2) * kstep; const char* b2 = last ? nB : cB + (size_t)(t + 2) * kstep;
            const char* a3 = a2 + kstep; const char* b3 = b2 + kstep;
            if (last && has_next) S.a_ready(nxt);
            if constexpr (SP2) {
            PG8_LDB(B0, 0, 0); PG8_LDB(B1, 0, 1); PG8_SCHED; PG8_LDA(At, 0, 0); PG8_STAGE(PG8_SA(1, 1), a1 + hstep, voffA);
            PG8_WAIT_V(8); PG8_WAIT_L(0); PG8_BAR; PG8_MMA(0, 0, At, B0); PG8_MMA(0, 1, At, B1); PG8_BAR; PG8_SCHED;
            PG8_LDA(At, 0, 1); PG8_STAGE(PG8_SB(0, 0), b2, voffB); PG8_STAGE(PG8_SB(0, 1), b2 + hstep, voffB); PG8_STAGE(PG8_SA(0, 0), a2, voffA);
            PG8_WAIT_V(8); PG8_WAIT_L(0); PG8_BAR; PG8_MMA(1, 0, At, B0); PG8_MMA(1, 1, At, B1); PG8_BAR; PG8_SCHED;
            PG8_LDB(B0, 1, 0); PG8_LDB(B1, 1, 1); PG8_SCHED; PG8_LDA(At, 1, 0); PG8_STAGE(PG8_SA(0, 1), a2 + hstep, voffA);
            PG8_WAIT_V(8); PG8_WAIT_L(0); PG8_BAR; PG8_MMA(0, 0, At, B0); PG8_MMA(0, 1, At, B1); PG8_BAR; PG8_SCHED;
            PG8_LDA(At, 1, 1); PG8_STAGE(PG8_SB(1, 0), b3, voffB); PG8_STAGE(PG8_SB(1, 1), b3 + hstep, voffB); PG8_STAGE(PG8_SA(1, 0), a3, voffA);
            PG8_WAIT_V(8); PG8_WAIT_L(0); PG8_BAR; PG8_MMA(1, 0, At, B0); PG8_MMA(1, 1, At, B1); PG8_BAR; PG8_SCHED;
            } else {
            PG8_LDB(B0, 0, 0); PG8_SCHED; PG8_LDA(At, 0, 0); PG8_STAGE(PG8_SA(1, 1), a1 + hstep, voffA);
            PG8_WAIT_L(8); PG8_BAR; PG8_WAIT_L(0); PG8_MMA(0, 0, At, B0); PG8_BAR; PG8_SCHED;
            PG8_LDB(B1, 0, 1); PG8_STAGE(PG8_SB(0, 0), b2, voffB);
            PG8_BAR; PG8_WAIT_L(0); PG8_MMA(0, 1, At, B1); PG8_BAR;
            PG8_LDA(At, 0, 1); PG8_STAGE(PG8_SA(0, 0), a2, voffA);
            PG8_BAR; PG8_WAIT_L(0); PG8_MMA(1, 0, At, B0); PG8_BAR; PG8_SCHED;
            PG8_STAGE(PG8_SB(0, 1), b2 + hstep, voffB);
            PG8_WAIT_V(6); PG8_BAR; PG8_MMA(1, 1, At, B1); PG8_BAR;
            PG8_LDB(B0, 1, 0); PG8_SCHED; PG8_LDA(At, 1, 0); PG8_STAGE(PG8_SA(0, 1), a2 + hstep, voffA);
            PG8_WAIT_L(8); PG8_BAR; PG8_WAIT_L(0); PG8_MMA(0, 0, At, B0); PG8_BAR; PG8_SCHED;
            PG8_LDB(B1, 1, 1); PG8_STAGE(PG8_SB(1, 0), b3, voffB);
            PG8_BAR; PG8_WAIT_L(0); PG8_MMA(0, 1, At, B1); PG8_BAR;
            PG8_LDA(At, 1, 1); PG8_STAGE(PG8_SA(1, 0), a3, voffA);
            PG8_BAR; PG8_WAIT_L(0); PG8_MMA(1, 0, At, B0); PG8_BAR; PG8_SCHED;
            PG8_STAGE(PG8_SB(1, 1), b3 + hstep, voffB);
            PG8_WAIT_V(6); PG8_BAR; PG8_MMA(1, 1, At, B1); PG8_BAR;
            }
        }
        if constexpr (ALIGN_EPI) { if (wr == 0) PG8_BAR; }
        if constexpr (!Epi::AFTER_DRAIN) { E(acc, cur, wr, wc, fr, fq); S.done(cur); }
        if (!has_next) break;
#pragma unroll
        for (int a = 0; a < 2; ++a)
#pragma unroll
            for (int b = 0; b < 2; ++b)
#pragma unroll
                for (int m = 0; m < 4; ++m)
#pragma unroll
                    for (int n = 0; n < 2; ++n) acc[a][b][m][n] = (f32x4){0.f, 0.f, 0.f, 0.f};
        cur = nxt; cA = nA; cB = nB; ++ui;
        if constexpr (ALIGN_EPI) { if (wr == 1) PG8_BAR; }
    }
    PG8_WAIT_V(0);
    if constexpr (!ALIGN_EPI) { if (wr == 0) PG8_BAR; }
    PG8_BAR;
    if constexpr (Epi::AFTER_DRAIN) { E.fused(acc, cur, wr, wc, fr, fq, lds, wid, lane); S.done(cur); }
#undef PG8_SA
#undef PG8_SB
#undef PG8_STAGE
#undef PG8_LDA
#undef PG8_LDB
#undef PG8_MMA
#undef PG8_WAIT_V
#undef PG8_WAIT_L
#undef PG8_BAR
#undef PG8_SCHED
}
}

constexpr int BATCH = 16, SEQ = 2048, D = 1024, M = BATCH * SEQ, FF = 2816, NGU = 2 * FF, NIN = 2304, NMOD = 9 * D;
constexpr float LN_EPS = 1e-5f;
constexpr float DN_ALPHA = 1.189207115002721f;
constexpr int NWAVES = 8;
static_assert(D == pg8::P_D && FF == pg8::P_FF && NIN == pg8::P_NIN && NMOD == pg8::P_NMOD && SEQ == pg8::P_SEQ, "shape constants");

constexpr size_t MiB = 1u << 20;
constexpr size_t WS_MOD = 0;
constexpr size_t WS_TAB = 1 * MiB;
constexpr size_t WS_WGU1 = 4 * MiB, WS_WGU2 = 16 * MiB;
constexpr size_t WS_WDN1 = 28 * MiB, WS_WDN2 = 34 * MiB;
constexpr size_t WS_WIN = 40 * MiB, WS_WOUT = 45 * MiB;
constexpr size_t WS_H = 48 * MiB;
constexpr size_t WS_HID = 112 * MiB;
constexpr size_t WS_PROJ = WS_HID, WS_VT = WS_HID + 144 * MiB;
constexpr size_t WS_Y = 288 * MiB;
constexpr size_t WS_END = 416 * MiB;

#define GAS __attribute__((address_space(1)))
#define LAS __attribute__((address_space(3)))
typedef unsigned short bf16;
typedef unsigned v4u __attribute__((ext_vector_type(4)));
typedef unsigned v2u __attribute__((ext_vector_type(2)));
typedef float f32x4 __attribute__((ext_vector_type(4)));
typedef float f32x16 __attribute__((ext_vector_type(16)));
typedef short bf16x8 __attribute__((ext_vector_type(8)));
#define LDS_WAIT() asm volatile("s_waitcnt lgkmcnt(0)" ::: "memory")
__device__ __forceinline__ unsigned f2bf(float f) { unsigned u = __builtin_bit_cast(unsigned, f); return (u + 0x7fffu + ((u >> 16) & 1u)) >> 16; }
__device__ __forceinline__ unsigned pk2(float lo, float hi) { return f2bf(lo) | (f2bf(hi) << 16); }
__device__ __forceinline__ float wave_sum(float v) {
#pragma unroll
    for (int o = 1; o < 64; o <<= 1) v += __shfl_xor(v, o);
    return v;
}

constexpr int RING_BYTES = 131072;
constexpr int LDS_BYTES = 135168;

struct Args {
    const float* x; const float* c; const int* pos; const float* w_ada; const float* b_ada;
    const float* gu1; const float* dn1; const float* ln1g; const float* ln1b;
    const float* w_in; const float* conv_w; const float* sinks; const float* w_out; const float* ln2g; const float* ln2b;
    const float* gu2; const float* dn2; const float* ln3g; const float* ln3b;
    float* out; unsigned char* ws; int ph_lo, ph_hi;
};

__device__ __forceinline__ void transpose_item(const float* W, int K, int N, bf16* WT, int k0, int n0, int out_row, LAS float* scr, int lane) {
#pragma unroll 8
    for (int i = 0; i < 32; ++i) { const int kk = 2 * i + (lane >> 5); scr[kk * 33 + (lane & 31)] = W[(size_t)(k0 + kk) * N + n0 + (lane & 31)]; }
    LDS_WAIT(); asm volatile("" ::: "memory");
    const int c = lane & 7;
#pragma unroll
    for (int j = 0; j < 4; ++j) { const int n = (lane >> 3) + 8 * j; const LAS float* s = scr + (8 * c) * 33 + n;
        v4u o; o.x = pk2(s[0 * 33], s[1 * 33]); o.y = pk2(s[2 * 33], s[3 * 33]); o.z = pk2(s[4 * 33], s[5 * 33]); o.w = pk2(s[6 * 33], s[7 * 33]);
        *(v4u*)(WT + (size_t)(out_row + n) * K + k0 + 8 * c) = o; }
    LDS_WAIT(); asm volatile("" ::: "memory");
}
__device__ __forceinline__ void tr_plain(const float* W, int K, int N, bf16* WT, int item, LAS float* scr, int lane) {
    const int nblk = N / 32, kb = item / nblk, nb = item % nblk;
    transpose_item(W, K, N, WT, 64 * kb, 32 * nb, 32 * nb, scr, lane);
}
__device__ __forceinline__ void tr_gu(const float* W, bf16* WT, int item, LAS float* scr, int lane) {
    const int nblk = NGU / 32, kb = item / nblk, nb = item % nblk; const int n0 = 32 * nb;
    const int up = (n0 >= FF) ? 1 : 0; const int j = n0 - up * FF;
    transpose_item(W, D, NGU, WT, 64 * kb, n0, 256 * (j >> 7) + 128 * up + (j & 127), scr, lane);
}

__device__ __forceinline__ void phase0(const Args& a, LAS unsigned char* lds, int tid, int lane, int wave) {
    float* mod = (float*)(a.ws + WS_MOD);
    if ((int)blockIdx.x < 144) {
        LAS float* sc = (LAS float*)lds;
        LAS float* red = (LAS float*)(lds + 65536);
        for (int i = tid; i < 16 * 1024; i += 512) { const float v = a.c[i]; sc[i] = v / (1.0f + __expf(-v)); }
        __syncthreads();
        for (int item = blockIdx.x; item < 144; item += gridDim.x) {
            const int n = 64 * item + lane; const int k0 = 128 * wave;
            float acc[16];
#pragma unroll
            for (int b = 0; b < 16; ++b) acc[b] = 0.f;
            const float* wp = a.w_ada + (size_t)k0 * NMOD + n;
#pragma unroll 4
            for (int k4 = 0; k4 < 128; k4 += 4) {
                const float w0 = wp[(size_t)(k4 + 0) * NMOD], w1 = wp[(size_t)(k4 + 1) * NMOD], w2 = wp[(size_t)(k4 + 2) * NMOD], w3 = wp[(size_t)(k4 + 3) * NMOD];
#pragma unroll
                for (int b = 0; b < 16; ++b) { const f32x4 s = *(const LAS f32x4*)(sc + b * 1024 + k0 + k4); acc[b] += (s.x * w0 + s.y * w1) + (s.z * w2 + s.w * w3); }
            }
#pragma unroll
            for (int b = 0; b < 16; ++b) red[(wave * 16 + b) * 64 + lane] = acc[b];
            __syncthreads();
            for (int o = tid; o < 1024; o += 512) { const int b = o >> 6, cidx = o & 63; float s = 0.f;
#pragma unroll
                for (int w = 0; w < 8; ++w) s += red[(w * 16 + b) * 64 + cidx];
                mod[(size_t)b * NMOD + 64 * item + cidx] = s + a.b_ada[64 * item + cidx]; }
            __syncthreads();
        }
    }
    __syncthreads();
    {
        LAS float* scr = (LAS float*)(lds + wave * 16384);
        const int gw = blockIdx.x * NWAVES + wave, NGW = gridDim.x * NWAVES;
        constexpr int I_GU = (D / 64) * (NGU / 32), I_DN = (FF / 64) * (D / 32), I_IN = (D / 64) * (NIN / 32), I_OUT = (D / 64) * (D / 32);
        constexpr int NITEMS = 2 * I_GU + 2 * I_DN + I_IN + I_OUT;
        for (int it = gw; it < NITEMS; it += NGW) {
            int r = it;
            if (r < I_GU) { tr_gu(a.gu1, (bf16*)(a.ws + WS_WGU1), r, scr, lane); continue; } r -= I_GU;
            if (r < I_GU) { tr_gu(a.gu2, (bf16*)(a.ws + WS_WGU2), r, scr, lane); continue; } r -= I_GU;
            if (r < I_DN) { tr_plain(a.dn1, FF, D, (bf16*)(a.ws + WS_WDN1), r, scr, lane); continue; } r -= I_DN;
            if (r < I_DN) { tr_plain(a.dn2, FF, D, (bf16*)(a.ws + WS_WDN2), r, scr, lane); continue; } r -= I_DN;
            if (r < I_IN) { tr_plain(a.w_in, D, NIN, (bf16*)(a.ws + WS_WIN), r, scr, lane); continue; } r -= I_IN;
            tr_plain(a.w_out, D, D, (bf16*)(a.ws + WS_WOUT), r, scr, lane);
        }
    }
    {
        float* tab = (float*)(a.ws + WS_TAB);
        const int gt = blockIdx.x * 512 + tid, NGT = gridDim.x * 512;
        for (int e = gt; e < M * 8; e += NGT) {
            const int tok = e >> 3, i = e & 7;
            const float invf = (i == 0) ? 1.0f : (i == 1) ? 1.939227432e-01f : (i == 2) ? 3.760603070e-02f : (i == 3) ? 7.292664610e-03f
                             : (i == 4) ? 1.414213562e-03f : (i == 5) ? 2.742481884e-04f : (i == 6) ? 5.318295734e-05f : 1.031338525e-05f;
            const float ang = (float)a.pos[tok] * invf;
            double rev = (double)ang * 0.15915494309189535; rev -= __builtin_rint(rev);
            const float f = (float)rev;
            tab[(size_t)tok * 16 + i] = __builtin_amdgcn_cosf(f);
            tab[(size_t)tok * 16 + 8 + i] = __builtin_amdgcn_sinf(f);
        }
    }
}

__device__ __forceinline__ void phase_mod(const float* x, const float* modsh, const float* modsc, bf16* h, int lane, int wave) {
    const int gw = blockIdx.x * NWAVES + wave, NGW = gridDim.x * NWAVES;
    for (int row = gw; row < M; row += NGW) {
        const int b = row >> 11;
        const f32x4* xr = (const f32x4*)(x + (size_t)row * D) + lane;
        const f32x4* shp = (const f32x4*)(modsh + (size_t)b * NMOD) + lane;
        const f32x4* scp = (const f32x4*)(modsc + (size_t)b * NMOD) + lane;
        v2u* o8 = (v2u*)(h + (size_t)row * D) + lane;
#pragma unroll
        for (int j = 0; j < 4; ++j) {
            const f32x4 v = xr[64 * j], sh = shp[64 * j], sc = scp[64 * j];
            const f32x4 r = v * (sc + 1.0f) + sh;
            v2u w; w.x = pk2(r.x, r.y); w.y = pk2(r.z, r.w); o8[64 * j] = w;
        }
    }
}

__device__ __forceinline__ void phase_ln(const float* y, const float* g, const float* bb, float* xo, const float* modsh, const float* modsc, bf16* h, int lane, int wave) {
    const int gw = blockIdx.x * NWAVES + wave, NGW = gridDim.x * NWAVES;
    f32x4 gv[4], bv[4];
#pragma unroll
    for (int j = 0; j < 4; ++j) { gv[j] = ((const f32x4*)g)[lane + 64 * j]; bv[j] = ((const f32x4*)bb)[lane + 64 * j]; }
    for (int row = gw; row < M; row += NGW) {
        const int b = row >> 11;
        const f32x4* yr = (const f32x4*)(y + (size_t)row * D) + lane;
        f32x4 v[4]; float s = 0.f;
#pragma unroll
        for (int j = 0; j < 4; ++j) { v[j] = yr[64 * j]; s += (v[j].x + v[j].y) + (v[j].z + v[j].w); }
        const float mean = wave_sum(s) * (1.f / D); float s2 = 0.f;
#pragma unroll
        for (int j = 0; j < 4; ++j) { v[j] = v[j] - mean; s2 += (v[j].x * v[j].x + v[j].y * v[j].y) + (v[j].z * v[j].z + v[j].w * v[j].w); }
        const float rstd = 1.f / sqrtf(wave_sum(s2) * (1.f / D) + LN_EPS);
        f32x4* xr = (f32x4*)(xo + (size_t)row * D) + lane;
#pragma unroll
        for (int j = 0; j < 4; ++j) { v[j] = v[j] * rstd * gv[j] + bv[j]; xr[64 * j] = v[j]; }
        if (h) {
            const f32x4* shp = (const f32x4*)(modsh + (size_t)b * NMOD) + lane;
            const f32x4* scp = (const f32x4*)(modsc + (size_t)b * NMOD) + lane;
            v2u* o8 = (v2u*)(h + (size_t)row * D) + lane;
#pragma unroll
            for (int j = 0; j < 4; ++j) { const f32x4 r = v[j] * (scp[64 * j] + 1.0f) + shp[64 * j]; v2u w; w.x = pk2(r.x, r.y); w.y = pk2(r.z, r.w); o8[64 * j] = w; }
        }
    }
}

__device__ __forceinline__ void attn_item(const bf16* P, const bf16* Vt, bf16* cat, float sink, int b, int kvh, int g, int qblk, int lane) {
    const int r32 = lane & 31, hi = lane >> 5;
    const int t0 = qblk * 32; const int hq = kvh * 4 + g;
    const size_t tokbase = (size_t)b * SEQ;
    const float SC = 0.125f * 1.4426950408889634f;
    bf16x8 qf[4];
    { const bf16* qp = P + (tokbase + t0 + r32) * NIN + hq * 64 + 8 * hi;
#pragma unroll
      for (int d0 = 0; d0 < 4; ++d0) qf[d0] = *(const bf16x8*)(qp + 16 * d0); }
    float m_run = sink * 1.4426950408889634f;
    float l_run = (hi == 0) ? 1.0f : 0.0f;
    f32x16 o0, o1;
#pragma unroll
    for (int r = 0; r < 16; ++r) { o0[r] = 0.f; o1[r] = 0.f; }
    const int keyperm = 16 * ((r32 >> 2) & 1) + (r32 & 3) + 4 * (r32 >> 3);
    const bf16* kbase = P + 512 + kvh * 64 + 8 * hi;
    const bf16* vbase = Vt + ((size_t)(b * 2 + kvh) * 64 + r32) * SEQ + 16 * hi;
    const int qp_ = t0 + r32;
    for (int tt = 0; tt < 5; ++tt) {
        const int kb = t0 - 128 + 32 * tt;
        if (kb < 0) continue;
        bf16x8 kf[4], vf[2][2];
        { const bf16* kp = kbase + (tokbase + kb + keyperm) * NIN;
#pragma unroll
          for (int d0 = 0; d0 < 4; ++d0) kf[d0] = *(const bf16x8*)(kp + 16 * d0); }
#pragma unroll
        for (int s = 0; s < 2; ++s)
#pragma unroll
            for (int dh = 0; dh < 2; ++dh) vf[s][dh] = *(const bf16x8*)(vbase + (size_t)dh * 32 * SEQ + kb + 8 * s);
        f32x16 sacc;
#pragma unroll
        for (int r = 0; r < 16; ++r) sacc[r] = 0.f;
#pragma unroll
        for (int d0 = 0; d0 < 4; ++d0) sacc = __builtin_amdgcn_mfma_f32_32x32x16_bf16(kf[d0], qf[d0], sacc, 0, 0, 0);
        float mx = -INFINITY;
#pragma unroll
        for (int r = 0; r < 16; ++r) { const int diff = qp_ - (kb + 16 * hi + r); const bool ok = (diff >= 0) && (diff < 128); sacc[r] = ok ? sacc[r] * SC : -INFINITY; mx = fmaxf(mx, sacc[r]); }
        mx = fmaxf(mx, __shfl_xor(mx, 32));
        const float m_new = fmaxf(m_run, mx);
        const float al = __builtin_amdgcn_exp2f(m_run - m_new);
        m_run = m_new;
        float ps = 0.f;
#pragma unroll
        for (int r = 0; r < 16; ++r) { sacc[r] = __builtin_amdgcn_exp2f(sacc[r] - m_new); ps += sacc[r]; }
        l_run = l_run * al + ps;
#pragma unroll
        for (int r = 0; r < 16; ++r) { o0[r] *= al; o1[r] *= al; }
        v4u pw0, pw1;
        pw0.x = pg8::cvt_pk_bf16(sacc[0], sacc[1]); pw0.y = pg8::cvt_pk_bf16(sacc[2], sacc[3]); pw0.z = pg8::cvt_pk_bf16(sacc[4], sacc[5]); pw0.w = pg8::cvt_pk_bf16(sacc[6], sacc[7]);
        pw1.x = pg8::cvt_pk_bf16(sacc[8], sacc[9]); pw1.y = pg8::cvt_pk_bf16(sacc[10], sacc[11]); pw1.z = pg8::cvt_pk_bf16(sacc[12], sacc[13]); pw1.w = pg8::cvt_pk_bf16(sacc[14], sacc[15]);
        const bf16x8 pb0 = __builtin_bit_cast(bf16x8, pw0), pb1 = __builtin_bit_cast(bf16x8, pw1);
        o0 = __builtin_amdgcn_mfma_f32_32x32x16_bf16(vf[0][0], pb0, o0, 0, 0, 0);
        o1 = __builtin_amdgcn_mfma_f32_32x32x16_bf16(vf[0][1], pb0, o1, 0, 0, 0);
        o0 = __builtin_amdgcn_mfma_f32_32x32x16_bf16(vf[1][0], pb1, o0, 0, 0, 0);
        o1 = __builtin_amdgcn_mfma_f32_32x32x16_bf16(vf[1][1], pb1, o1, 0, 0, 0);
    }
    const float lt = l_run + __shfl_xor(l_run, 32);
    const float inv = 1.0f / lt;
    bf16* op = cat + (tokbase + t0 + r32) * D + hq * 64 + 4 * hi;
#pragma unroll
    for (int q4 = 0; q4 < 4; ++q4) {
        v2u w0, w1;
        w0.x = pg8::cvt_pk_bf16(o0[4 * q4 + 0] * inv, o0[4 * q4 + 1] * inv); w0.y = pg8::cvt_pk_bf16(o0[4 * q4 + 2] * inv, o0[4 * q4 + 3] * inv);
        w1.x = pg8::cvt_pk_bf16(o1[4 * q4 + 0] * inv, o1[4 * q4 + 1] * inv); w1.y = pg8::cvt_pk_bf16(o1[4 * q4 + 2] * inv, o1[4 * q4 + 3] * inv);
        *(v2u*)(op + 8 * q4) = w0; *(v2u*)(op + 32 + 8 * q4) = w1;
    }
}

__device__ __forceinline__ float bf_lo(unsigned w) { return __builtin_bit_cast(float, w << 16); }
__device__ __forceinline__ float bf_hi(unsigned w) { return __builtin_bit_cast(float, w & 0xffff0000u); }

__device__ __forceinline__ void conv_item(const bf16* P, const float* cw, bf16* cat, int item, int lane) {
    const int tokb = item * 16; const int ch = 8 * lane;
    float w0[8], w1[8], w2[8];
#pragma unroll
    for (int j = 0; j < 8; ++j) { w0[j] = cw[ch + j]; w1[j] = cw[512 + ch + j]; w2[j] = cw[1024 + ch + j]; }
    float z1[8], z2[8];
#pragma unroll
    for (int j = 0; j < 8; ++j) { z1[j] = 0.f; z2[j] = 0.f; }
    const int s0 = tokb & (SEQ - 1);
    for (int t = -2; t < 16; ++t) {
        if (s0 + t < 0) continue;
        const bf16* rp = P + (size_t)(tokb + t) * NIN + 768 + ch;
        const v4u uu = *(const v4u*)(rp), cc = *(const v4u*)(rp + 1024);
        float z[8];
        z[0] = bf_lo(uu.x) * bf_lo(cc.x); z[1] = bf_hi(uu.x) * bf_hi(cc.x); z[2] = bf_lo(uu.y) * bf_lo(cc.y); z[3] = bf_hi(uu.y) * bf_hi(cc.y);
        z[4] = bf_lo(uu.z) * bf_lo(cc.z); z[5] = bf_hi(uu.z) * bf_hi(cc.z); z[6] = bf_lo(uu.w) * bf_lo(cc.w); z[7] = bf_hi(uu.w) * bf_hi(cc.w);
        if (t >= 0) {
            const v4u bg = *(const v4u*)(rp + 512);
            float y[8];
#pragma unroll
            for (int j = 0; j < 8; ++j) y[j] = w0[j] * z2[j] + w1[j] * z1[j] + w2[j] * z[j];
            v4u o;
            o.x = pg8::cvt_pk_bf16(bf_lo(bg.x) * y[0], bf_hi(bg.x) * y[1]); o.y = pg8::cvt_pk_bf16(bf_lo(bg.y) * y[2], bf_hi(bg.y) * y[3]);
            o.z = pg8::cvt_pk_bf16(bf_lo(bg.z) * y[4], bf_hi(bg.z) * y[5]); o.w = pg8::cvt_pk_bf16(bf_lo(bg.w) * y[6], bf_hi(bg.w) * y[7]);
            *(v4u*)(cat + (size_t)(tokb + t) * D + 512 + ch) = o;
        }
#pragma unroll
        for (int j = 0; j < 8; ++j) { z2[j] = z1[j]; z1[j] = z[j]; }
    }
}

__device__ __forceinline__ void phase_mixer(const Args& a, int lane, int wave) {
    const bf16* P = (const bf16*)(a.ws + WS_PROJ); const bf16* Vt = (const bf16*)(a.ws + WS_VT); bf16* cat = (bf16*)(a.ws + WS_H);
    for (int it = blockIdx.x; it < BATCH * 2 * (SEQ / 64); it += gridDim.x) {
        const int qb64 = it & 31, kvh = (it >> 5) & 1, b = it >> 6;
        const int g = wave & 3, sub = wave >> 2;
        attn_item(P, Vt, cat, a.sinks[kvh * 4 + g], b, kvh, g, qb64 * 2 + sub, lane);
    }
    const int gw = blockIdx.x * NWAVES + wave, NGW = gridDim.x * NWAVES;
    for (int it = gw; it < M / 16; it += NGW) conv_item(P, a.conv_w, cat, it, lane);
}

constexpr int N_PHASES = 12;
__global__ void __launch_bounds__(NWAVES * 64, 2) mega_fwd(Args a) {
    extern __shared__ __attribute__((aligned(16))) unsigned char lds_raw[];
    LAS unsigned char* lds = (LAS unsigned char*)lds_raw;
    const int tid = threadIdx.x, lane = tid & 63, wave = __builtin_amdgcn_readfirstlane(tid >> 6);
    const int lo = a.ph_lo, hi = a.ph_hi;
    unsigned char* ws = a.ws;
    float* mod = (float*)(ws + WS_MOD);
    bf16* H = (bf16*)(ws + WS_H); bf16* HID = (bf16*)(ws + WS_HID); float* Y = (float*)(ws + WS_Y);
#define IN(k) (lo <= (k) && (k) < hi)
#if MK_SPLIT
#define SEAM(k) do {} while (0)
#else
#define SEAM(k) do { if (IN(k) && IN((k) + 1)) { __threadfence(); cg::this_grid().sync(); } } while (0)
#endif
    if (IN(0)) { phase0(a, lds, tid, lane, wave); }
    SEAM(0);
    if (IN(1)) { phase_mod(a.x, mod + 0 * D, mod + 1 * D, H, lane, wave); }
    SEAM(1);
    if (IN(2)) {
        pg8::Gemm g{H, (const bf16*)(ws + WS_WGU1), M, NGU, D}; pg8::StaticOrder S; S.init(M, NGU, gridDim.x, (int)blockIdx.x);
        pg8::EpiSwiGLU E{HID};
        pg8::gemm_phase<pg8::EpiSwiGLU, pg8::StaticOrder, true, true>(lds, g, S, E);
    }
    SEAM(2);
    if (IN(3)) {
        pg8::Gemm g{HID, (const bf16*)(ws + WS_WDN1), M, D, FF}; pg8::StaticOrder S; S.init(M, D, gridDim.x, (int)blockIdx.x);
        pg8::EpiResid E{a.x, Y, mod + 2 * D, 0.5f, DN_ALPHA};
        pg8::gemm_phase<pg8::EpiResid, pg8::StaticOrder, true, true>(lds, g, S, E);
    }
    SEAM(3);
    if (IN(4)) { phase_ln(Y, a.ln1g, a.ln1b, a.out, mod + 3 * D, mod + 4 * D, H, lane, wave); }
    SEAM(4);
    if (IN(5)) {
        pg8::Gemm g{H, (const bf16*)(ws + WS_WIN), M, NIN, D}; pg8::StaticOrder S; S.init(M, NIN, gridDim.x, (int)blockIdx.x);
        pg8::EpiProj E{(bf16*)(ws + WS_PROJ), (bf16*)(ws + WS_VT), (const float*)(ws + WS_TAB)};
        pg8::gemm_phase<pg8::EpiProj, pg8::StaticOrder, true, true>(lds, g, S, E);
    }
    SEAM(5);
    if (IN(6)) { phase_mixer(a, lane, wave); }
    SEAM(6);
    if (IN(7)) {
        pg8::Gemm g{H, (const bf16*)(ws + WS_WOUT), M, D, D}; pg8::StaticOrder S; S.init(M, D, gridDim.x, (int)blockIdx.x);
        pg8::EpiResid E{a.out, Y, mod + 5 * D, 1.0f, DN_ALPHA};
        pg8::gemm_phase<pg8::EpiResid, pg8::StaticOrder, true, true>(lds, g, S, E);
    }
    SEAM(7);
    if (IN(8)) { phase_ln(Y, a.ln2g, a.ln2b, a.out, mod + 6 * D, mod + 7 * D, H, lane, wave); }
    SEAM(8);
    if (IN(9)) {
        pg8::Gemm g{H, (const bf16*)(ws + WS_WGU2), M, NGU, D}; pg8::StaticOrder S; S.init(M, NGU, gridDim.x, (int)blockIdx.x);
        pg8::EpiSwiGLU E{HID};
        pg8::gemm_phase<pg8::EpiSwiGLU, pg8::StaticOrder, true, true>(lds, g, S, E);
    }
    SEAM(9);
    if (IN(10)) {
        pg8::Gemm g{HID, (const bf16*)(ws + WS_WDN2), M, D, FF}; pg8::StaticOrder S; S.init(M, D, gridDim.x, (int)blockIdx.x);
        pg8::EpiResid E{a.out, Y, mod + 8 * D, 0.5f, DN_ALPHA};
        pg8::gemm_phase<pg8::EpiResid, pg8::StaticOrder, true, true>(lds, g, S, E);
    }
    SEAM(10);
    if (IN(11)) { phase_ln(Y, a.ln3g, a.ln3b, a.out, nullptr, nullptr, nullptr, lane, wave); }
#undef IN
#undef SEAM
}

extern "C" void kernel_launch(void* const* d_in, const int* in_sizes, int n_in, void* d_out, int out_size, void* d_ws, size_t ws_size, hipStream_t stream) {
    static int grid = 0;
    if (grid == 0) {
        if (n_in != 19 || in_sizes[0] != M * D || out_size != M * D || ws_size < WS_END) { fprintf(stderr, "kernel_launch: unexpected shapes (n_in %d, in0 %d, out %d, ws %zu); nothing launched\n", n_in, n_in > 0 ? in_sizes[0] : -1, out_size, ws_size); grid = -1; return; }
        int dev = 0, cus = 0, per_cu = 0;
        if (hipGetDevice(&dev) != hipSuccess || hipDeviceGetAttribute(&cus, hipDeviceAttributeMultiprocessorCount, dev) != hipSuccess) { grid = -1; return; }
        if (hipFuncSetAttribute((const void*)mega_fwd, hipFuncAttributeMaxDynamicSharedMemorySize, LDS_BYTES) != hipSuccess) { fprintf(stderr, "kernel_launch: hipFuncSetAttribute failed\n"); grid = -1; return; }
        if (hipOccupancyMaxActiveBlocksPerMultiprocessor(&per_cu, (const void*)mega_fwd, NWAVES * 64, LDS_BYTES) != hipSuccess || per_cu < 1) { fprintf(stderr, "kernel_launch: occupancy query says %d\n", per_cu); per_cu = 1; }
        (void)hipGetLastError();
        grid = cus * per_cu;
    }
    if (grid < 0) return;
    Args a{};
    a.x = (const float*)d_in[0]; a.c = (const float*)d_in[1]; a.pos = (const int*)d_in[2]; a.w_ada = (const float*)d_in[3]; a.b_ada = (const float*)d_in[4];
    a.gu1 = (const float*)d_in[5]; a.dn1 = (const float*)d_in[6]; a.ln1g = (const float*)d_in[7]; a.ln1b = (const float*)d_in[8];
    a.w_in = (const float*)d_in[9]; a.conv_w = (const float*)d_in[10]; a.sinks = (const float*)d_in[11]; a.w_out = (const float*)d_in[12]; a.ln2g = (const float*)d_in[13]; a.ln2b = (const float*)d_in[14];
    a.gu2 = (const float*)d_in[15]; a.dn2 = (const float*)d_in[16]; a.ln3g = (const float*)d_in[17]; a.ln3b = (const float*)d_in[18];
    a.out = (float*)d_out; a.ws = (unsigned char*)d_ws;
#if MK_SPLIT
    for (int p = 0; p < N_PHASES; ++p) {
        a.ph_lo = p; a.ph_hi = p + 1;
        hipLaunchKernelGGL(mega_fwd, dim3(grid), dim3(NWAVES * 64), LDS_BYTES, stream, a);
    }
#else
    a.ph_lo = 0; a.ph_hi = N_PHASES;
    void* kargs[] = {&a};
    hipError_t e = hipLaunchCooperativeKernel((const void*)mega_fwd, dim3(grid), dim3(NWAVES * 64), kargs, LDS_BYTES, stream);
    if (e != hipSuccess) fprintf(stderr, "kernel_launch: cooperative launch failed: %s (grid %d)\n", hipGetErrorString(e), grid);
#endif
}
```

```cpp
#include <hip/hip_runtime.h>
#include <hip/hip_cooperative_groups.h>
#include <cstdio>
#include <cstdint>
namespace cg = cooperative_groups;

#ifndef MK_SPLIT
#define MK_SPLIT 0
#endif

namespace pg8 {
#define PG8_LAS __attribute__((address_space(3)))
typedef unsigned short bf16_t;
typedef short bf16x8 __attribute__((ext_vector_type(8)));
typedef float f32x4 __attribute__((ext_vector_type(4)));
typedef unsigned u32x4 __attribute__((ext_vector_type(4)));
constexpr int BM = 256, BK = 64, HALF = 128, HTB = HALF * BK * 2  , STAGE_BYTES = 8 * HTB, NXCD = 8, WGM = 8;

__host__ __device__ __forceinline__ int lds_byte(int r, int c) { const int st = (r >> 4) * 2 + (c >> 5), rr = r & 15, cc = c & 31, ob = rr * 64 + cc * 2; return st * 1024 + (ob ^ (((ob >> 9) & 1) << 5)); }
__host__ __device__ __forceinline__ void stage_rc(int b, int& R, int& C) { const int st = b / 1024, sb = b % 1024, swz = sb ^ (((sb >> 9) & 1) << 5); R = (st >> 1) * 16 + swz / 64; C = (st & 1) * 32 + (swz % 64) / 2; }
__host__ __device__ __forceinline__ int perm32(int rho) { const int n = rho >> 4, i = rho & 15; return 8 * (i >> 2) + 4 * n + (i & 3); }

struct Unit { int pm, pn; };
struct Gemm { const bf16_t* A; const bf16_t* Bt; int M, N, K; };

struct StaticOrder {
    int nM, nN, nwg, G, c;
    __host__ __device__ void init(int M, int N, int G_, int c_) { nM = M / BM; nN = N / BM; nwg = nM * nN; G = G_; c = c_; }
    __host__ __device__ bool next(int i, Unit& u) const {
        const long L = (long)i * G + c; if (L >= nwg) return false;
        int wgid = (int)L; { const int q = nwg / NXCD, r = nwg % NXCD, xcd = wgid % NXCD, off = wgid / NXCD; wgid = (xcd < r ? xcd * (q + 1) : r * (q + 1) + (xcd - r) * q) + off; }
        const int nig = WGM * nN, gid = wgid / nig, fm = gid * WGM, gsz = (nM - fm) < WGM ? (nM - fm) : WGM;
        u.pm = fm + ((wgid % nig) % gsz); u.pn = (wgid % nig) / gsz; return true;
    }
    __device__ __forceinline__ void a_ready(const Unit&) const {}
    __device__ __forceinline__ void done(const Unit&) const {}
};

constexpr int P_D = 1024, P_FF = 2816, P_NIN = 2304, P_NMOD = 9216, P_SEQ = 2048;
__device__ __forceinline__ unsigned cvt_pk_bf16(float lo, float hi) { unsigned r; asm volatile("v_cvt_pk_bf16_f32 %0, %1, %2" : "=v"(r) : "v"(lo), "v"(hi)); return r; }
__device__ __forceinline__ float silu_f(float g) { return g * __builtin_amdgcn_rcpf(1.0f + __expf(-g)); }

struct EpiSwiGLU {
    static constexpr bool PERM = true, AFTER_DRAIN = false;
    bf16_t* O;
    __device__ __forceinline__ void operator()(const f32x4 (&acc)[2][2][4][2], const Unit& u, int wr, int wc, int fr, int fq) const {
        const int row0 = u.pm * BM + wr * 64 + fr; const int col0 = u.pn * HALF + wc * 32 + 8 * fq;
#pragma unroll
        for (int ai = 0; ai < 2; ++ai)
#pragma unroll
            for (int m = 0; m < 4; ++m) {
                bf16_t* rowp = O + (size_t)(row0 + ai * HALF + m * 16) * P_FF + col0;
                const f32x4 g0 = acc[ai][0][m][0], g1 = acc[ai][0][m][1], u0 = acc[ai][1][m][0], u1 = acc[ai][1][m][1];
                u32x4 w;
                w.x = cvt_pk_bf16(silu_f(g0[0]) * u0[0], silu_f(g0[1]) * u0[1]);
                w.y = cvt_pk_bf16(silu_f(g0[2]) * u0[2], silu_f(g0[3]) * u0[3]);
                w.z = cvt_pk_bf16(silu_f(g1[0]) * u1[0], silu_f(g1[1]) * u1[1]);
                w.w = cvt_pk_bf16(silu_f(g1[2]) * u1[2], silu_f(g1[3]) * u1[3]);
                *(u32x4*)rowp = w;
            }
    }
};

struct EpiResid {
    static constexpr bool PERM = false, AFTER_DRAIN = false;
    const float* xres; float* y; const float* gate; float coef; float alpha;
    __device__ __forceinline__ void operator()(const f32x4 (&acc)[2][2][4][2], const Unit& u, int wr, int wc, int fr, int fq) const {
        const int row0 = u.pm * BM + wr * 64 + fr; const int col0 = u.pn * BM + wc * 32 + 4 * fq;
        const float* gp = gate + (size_t)(u.pm >> 3) * P_NMOD + col0;
        f32x4 gv[2][2];
#pragma unroll
        for (int bj = 0; bj < 2; ++bj)
#pragma unroll
            for (int n = 0; n < 2; ++n) { const f32x4 t = *(const f32x4*)(gp + bj * HALF + n * 16); gv[bj][n] = (t + 1.0f) * coef; }
#pragma unroll
        for (int ai = 0; ai < 2; ++ai)
#pragma unroll
            for (int m = 0; m < 4; ++m) {
                const size_t off = (size_t)(row0 + ai * HALF + m * 16) * P_D + col0;
#pragma unroll
                for (int bj = 0; bj < 2; ++bj)
#pragma unroll
                    for (int n = 0; n < 2; ++n) {
                        const f32x4 xv = *(const f32x4*)(xres + off + bj * HALF + n * 16);
                        *(f32x4*)(y + off + bj * HALF + n * 16) = xv * alpha + gv[bj][n] * acc[ai][bj][m][n];
                    }
            }
    }
};

struct EpiProj {
    static constexpr bool PERM = true, AFTER_DRAIN = false;
    bf16_t* P; bf16_t* Vt; const float* tab;
    __device__ __forceinline__ void operator()(const f32x4 (&acc)[2][2][4][2], const Unit& u, int wr, int wc, int fr, int fq) const {
        const int row0 = u.pm * BM + wr * 64 + fr;
#pragma unroll
        for (int bj = 0; bj < 2; ++bj) {
            const int tilecol = u.pn * BM + bj * HALF;
            const int cb = tilecol + wc * 32 + 8 * fq;
            const bool is_v = (tilecol == 640);
            const bool rope = (tilecol < 640) && ((wc & 1) == 0);
#pragma unroll
            for (int ai = 0; ai < 2; ++ai)
#pragma unroll
                for (int m = 0; m < 4; ++m) {
                    const int row = row0 + ai * HALF + m * 16;
                    f32x4 v0 = acc[ai][bj][m][0], v1 = acc[ai][bj][m][1];
                    if (rope) {
                        f32x4 p0, p1;
#pragma unroll
                        for (int j = 0; j < 4; ++j) { p0[j] = __shfl_xor(v0[j], 16); p1[j] = __shfl_xor(v1[j], 16); }
                        if (fq < 2) {
                            const float* tp = tab + (size_t)row * 16;
                            const f32x4 c0 = *(const f32x4*)(tp), c1 = *(const f32x4*)(tp + 4), s0 = *(const f32x4*)(tp + 8), s1 = *(const f32x4*)(tp + 12);
                            const float sg = (fq == 0) ? -1.0f : 1.0f;
                            v0 = v0 * c0 + (p0 * s0) * sg; v1 = v1 * c1 + (p1 * s1) * sg;
                        }
                    }
                    if (is_v) {
                        const int b = row >> 11, s = row & (P_SEQ - 1);
                        const int colv = wc * 32 + 8 * fq;
                        bf16_t* vp = Vt + ((size_t)(b * 2 + (colv >> 6)) * 64 + (colv & 63)) * P_SEQ + s;
                        const unsigned w0 = cvt_pk_bf16(v0[0], v0[1]), w1 = cvt_pk_bf16(v0[2], v0[3]), w2 = cvt_pk_bf16(v1[0], v1[1]), w3 = cvt_pk_bf16(v1[2], v1[3]);
                        vp[0 * P_SEQ] = (bf16_t)(w0 & 0xffffu); vp[1 * P_SEQ] = (bf16_t)(w0 >> 16);
                        vp[2 * P_SEQ] = (bf16_t)(w1 & 0xffffu); vp[3 * P_SEQ] = (bf16_t)(w1 >> 16);
                        vp[4 * P_SEQ] = (bf16_t)(w2 & 0xffffu); vp[5 * P_SEQ] = (bf16_t)(w2 >> 16);
                        vp[6 * P_SEQ] = (bf16_t)(w3 & 0xffffu); vp[7 * P_SEQ] = (bf16_t)(w3 >> 16);
                    } else {
                        u32x4 w; w.x = cvt_pk_bf16(v0[0], v0[1]); w.y = cvt_pk_bf16(v0[2], v0[3]); w.z = cvt_pk_bf16(v1[0], v1[1]); w.w = cvt_pk_bf16(v1[2], v1[3]);
                        *(u32x4*)(P + (size_t)row * P_NIN + cb) = w;
                    }
                }
        }
    }
};

template <class Epi, class Sched, bool ALIGN_EPI = false, bool SP2 = false>
__device__ __forceinline__ void gemm_phase(PG8_LAS unsigned char* lds, const Gemm g, const Sched& S, const Epi& E) {
    const int tid = threadIdx.x, wid = __builtin_amdgcn_readfirstlane(tid >> 6), lane = tid & 63, wr = wid >> 2, wc = wid & 3, fr = lane & 15, fq = lane >> 4;
    const int K = g.K, nt = K / BK;
    unsigned voffA[2], voffB[2];
#pragma unroll
    for (int i = 0; i < 2; ++i) { int R, C; stage_rc(tid * 16 + i * 8192, R, C); const int Rb = Epi::PERM ? ((R & ~31) + perm32(R & 31)) : R;
        voffA[i] = (unsigned)(R * K + C) * 2u; voffB[i] = (unsigned)(Rb * K + C) * 2u; }
    const size_t kstep = (size_t)(BK * 2);
    const size_t hstep = (size_t)HALF * K * 2;
    const size_t tstep = 2 * hstep;
    const unsigned ldsw = (unsigned)wid * 1024u;
    const int aoff = lds_byte(wr * 64 + fr, fq * 8), boff = lds_byte(wc * 32 + fr, fq * 8);
#define PG8_SA(b, h) (((b) * 2 + (h)) * HTB)
#define PG8_SB(b, h) ((4 + (b) * 2 + (h)) * HTB)
#define PG8_STAGE(bufoff, gbase, voff) do { _Pragma("unroll") for (int _i = 0; _i < 2; ++_i) \
        __builtin_amdgcn_global_load_lds((const unsigned*)((const char*)(gbase) + (voff)[_i]), (PG8_LAS unsigned*)(lds + (bufoff) + ldsw + _i * 8192), 16, 0, 0); } while (0)
#define PG8_LDA(dst, b, h) do { _Pragma("unroll") for (int m = 0; m < 4; ++m) _Pragma("unroll") for (int k = 0; k < 2; ++k) dst[m][k] = *(const PG8_LAS bf16x8*)(lds + PG8_SA(b, h) + aoff + m * 2048 + k * 1024); } while (0)
#define PG8_LDB(dst, b, h) do { _Pragma("unroll") for (int n = 0; n < 2; ++n) _Pragma("unroll") for (int k = 0; k < 2; ++k) dst[n][k] = *(const PG8_LAS bf16x8*)(lds + PG8_SB(b, h) + boff + n * 2048 + k * 1024); } while (0)
#define PG8_MMA(ai, bj, At, Bt) do { __builtin_amdgcn_s_setprio(1); _Pragma("unroll") for (int m = 0; m < 4; ++m) _Pragma("unroll") for (int n = 0; n < 2; ++n) _Pragma("unroll") for (int k = 0; k < 2; ++k) \
        acc[ai][bj][m][n] = __builtin_amdgcn_mfma_f32_16x16x32_bf16(Bt[n][k], At[m][k], acc[ai][bj][m][n], 0, 0, 0); __builtin_amdgcn_s_setprio(0); } while (0)
#define PG8_WAIT_V(n) asm volatile("s_waitcnt vmcnt(" #n ")" ::: "memory")
#define PG8_WAIT_L(n) asm volatile("s_waitcnt lgkmcnt(" #n ")" ::: "memory")
#define PG8_BAR __builtin_amdgcn_s_barrier()
#define PG8_SCHED __builtin_amdgcn_sched_barrier(0)
    Unit cur, nxt; int ui = 0;
    if (!S.next(0, cur)) return;
    f32x4 acc[2][2][4][2];
#pragma unroll
    for (int a = 0; a < 2; ++a)
#pragma unroll
        for (int b = 0; b < 2; ++b)
#pragma unroll
            for (int m = 0; m < 4; ++m)
#pragma unroll
                for (int n = 0; n < 2; ++n) acc[a][b][m][n] = (f32x4){0.f, 0.f, 0.f, 0.f};
    bf16x8 At[4][2], B0[2][2], B1[2][2];
    const char* cA = (const char*)g.A + (size_t)cur.pm * tstep; const char* cB = (const char*)g.Bt + (size_t)cur.pn * tstep;
    S.a_ready(cur);
    if constexpr (SP2) {
        PG8_STAGE(PG8_SB(0, 0), cB, voffB); PG8_STAGE(PG8_SB(0, 1), cB + hstep, voffB); PG8_STAGE(PG8_SA(0, 0), cA, voffA); PG8_STAGE(PG8_SA(0, 1), cA + hstep, voffA);
        if (wr == 1) PG8_BAR;
        PG8_WAIT_V(2); PG8_BAR;
        PG8_STAGE(PG8_SB(1, 0), cB + kstep, voffB); PG8_STAGE(PG8_SA(1, 0), cA + kstep, voffA); PG8_STAGE(PG8_SB(1, 1), cB + hstep + kstep, voffB);
        PG8_WAIT_V(6); PG8_BAR;
    } else {
        PG8_STAGE(PG8_SB(0, 0), cB, voffB); PG8_STAGE(PG8_SA(0, 0), cA, voffA); PG8_STAGE(PG8_SB(0, 1), cB + hstep, voffB); PG8_STAGE(PG8_SA(0, 1), cA + hstep, voffA);
        if (wr == 1) PG8_BAR;
        PG8_WAIT_V(4); PG8_BAR;
        PG8_STAGE(PG8_SB(1, 0), cB + kstep, voffB); PG8_STAGE(PG8_SA(1, 0), cA + kstep, voffA); PG8_STAGE(PG8_SB(1, 1), cB + hstep + kstep, voffB);
        PG8_WAIT_V(6); PG8_BAR;
    }
    for (;;) {
        const bool has_next = S.next(ui + 1, nxt);
        const char* nA = has_next ? (const char*)g.A + (size_t)nxt.pm * tstep : cA; const char* nB = has_next ? (const char*)g.Bt + (size_t)nxt.pn * tstep : cB;
        for (int t = 0; t < nt; t += 2) {
            const bool last = (t == nt - 2);
            const char* a1 = cA + (size_t)(t + 1) * kstep;
            const char* a2 = last ? nA : cA + (size_t)(t + 2) * kstep; const char* b2 = last ? nB : cB + (size_t)(t + 2) * kstep;
            const char* a3 = a2 + kstep; const char* b3 = b2 + kstep;
            if (last && has_next) S.a_ready(nxt);
            if constexpr (SP2) {
            PG8_LDB(B0, 0, 0); PG8_LDB(B1, 0, 1); PG8_SCHED; PG8_LDA(At, 0, 0); PG8_STAGE(PG8_SA(1, 1), a1 + hstep, voffA);
            PG8_WAIT_V(8); PG8_WAIT_L(0); PG8_BAR; PG8_MMA(0, 0, At, B0); PG8_MMA(0, 1, At, B1); PG8_BAR; PG8_SCHED;
            PG8_LDA(At, 0, 1); PG8_STAGE(PG8_SB(0, 0), b2, voffB); PG8_STAGE(PG8_SB(0, 1), b2 + hstep, voffB); PG8_STAGE(PG8_SA(0, 0), a2, voffA);
            PG8_WAIT_V(8); PG8_WAIT_L(0); PG8_BAR; PG8_MMA(1, 0, At, B0); PG8_MMA(1, 1, At, B1); PG8_BAR; PG8_SCHED;
            PG8_LDB(B0, 1, 0); PG8_LDB(B1, 1, 1); PG8_SCHED; PG8_LDA(At, 1, 0); PG8_STAGE(PG8_SA(0, 1), a2 + hstep, voffA);
            PG8_WAIT_V(8); PG8_WAIT_L(0); PG8_BAR; PG8_MMA(0, 0, At, B0); PG8_MMA(0, 1, At, B1); PG8_BAR; PG8_SCHED;
            PG8_LDA(At, 1, 1); PG8_STAGE(PG8_SB(1, 0), b3, voffB); PG8_STAGE(PG8_SB(1, 1), b3 + hstep, voffB); PG8_STAGE(PG8_SA(1, 0), a3, voffA);
            PG8_WAIT_V(8); PG8_WAIT_L(0); PG8_BAR; PG8_MMA(1, 0, At, B0); PG8_MMA(1, 1, At, B1); PG8_BAR; PG8_SCHED;
            } else {
            PG8_LDB(B0, 0, 0); PG8_SCHED; PG8_LDA(At, 0, 0); PG8_STAGE(PG8_SA(1, 1), a1 + hstep, voffA);
            PG8_WAIT_L(8); PG8_BAR; PG8_WAIT_L(0); PG8_MMA(0, 0, At, B0); PG8_BAR; PG8_SCHED;
            PG8_LDB(B1, 0, 1); PG8_STAGE(PG8_SB(0, 0), b2, voffB);
            PG8_BAR; PG8_WAIT_L(0); PG8_MMA(0, 1, At, B1); PG8_BAR;
            PG8_LDA(At, 0, 1); PG8_STAGE(PG8_SA(0, 0), a2, voffA);
            PG8_BAR; PG8_WAIT_L(0); PG8_MMA(1, 0, At, B0); PG8_BAR; PG8_SCHED;
            PG8_STAGE(PG8_SB(0, 1), b2 + hstep, voffB);
            PG8_WAIT_V(6); PG8_BAR; PG8_MMA(1, 1, At, B1); PG8_BAR;
            PG8_LDB(B0, 1, 0); PG8_SCHED; PG8_LDA(At, 1, 0); PG8_STAGE(PG8_SA(0, 1), a2 + hstep, voffA);
            PG8_WAIT_L(8); PG8_BAR; PG8_WAIT_L(0); PG8_MMA(0, 0, At, B0); PG8_BAR; PG8_SCHED;
            PG8_LDB(B1, 1, 1); PG8_STAGE(PG8_SB(1, 0), b3, voffB);
            PG8_BAR; PG8_WAIT_L(0); PG8_MMA(0, 1, At, B1); PG8_BAR;
            PG8_LDA(At, 1, 1); PG8_STAGE(PG8_SA(1, 0), a3, voffA);
            PG8_BAR; PG8_WAIT_L(0); PG8_MMA(1, 0, At, B0); PG8_BAR; PG8_SCHED;
            PG8_STAGE(PG8_SB(1, 1), b3 + hstep, voffB);
            PG8_WAIT_V(6); PG8_BAR; PG8_MMA(1, 1, At, B1); PG8_BAR;
            }
        }
        if constexpr (ALIGN_EPI) { if (wr == 0) PG8_BAR; }
        if constexpr (!Epi::AFTER_DRAIN) { E(acc, cur, wr, wc, fr, fq); S.done(cur); }
        if (!has_next) break;
#pragma unroll
        for (int a = 0; a < 2; ++a)
#pragma unroll
            for (int b = 0; b < 2; ++b)
#pragma unroll
                for (int m = 0; m < 4; ++m)
#pragma unroll
                    for (int n = 0; n < 2; ++n) acc[a][b][m][n] = (f32x4){0.f, 0.f, 0.f, 0.f};
        cur = nxt; cA = nA; cB = nB; ++ui;
        if constexpr (ALIGN_EPI) { if (wr == 1) PG8_BAR; }
    }
    PG8_WAIT_V(0);
    if constexpr (!ALIGN_EPI) { if (wr == 0) PG8_BAR; }
    PG8_BAR;
    if constexpr (Epi::AFTER_DRAIN) { E.fused(acc, cur, wr, wc, fr, fq, lds, wid, lane); S.done(cur); }
#undef PG8_SA
#undef PG8_SB
#undef PG8_STAGE
#undef PG8_LDA
#undef PG8_LDB
#undef PG8_MMA
#undef PG8_WAIT_V
#undef PG8_WAIT_L
#undef PG8_BAR
#undef PG8_SCHED
}
}

constexpr int BATCH = 16, SEQ = 2048, D = 1024, M = BATCH * SEQ, FF = 2816, NGU = 2 * FF, NIN = 2304, NMOD = 9 * D;
constexpr float LN_EPS = 1e-5f;
constexpr float DN_ALPHA = 1.189207115002721f;
constexpr int NWAVES = 8;
static_assert(D == pg8::P_D && FF == pg8::P_FF && NIN == pg8::P_NIN && NMOD == pg8::P_NMOD && SEQ == pg8::P_SEQ, "shape constants");

constexpr size_t MiB = 1u << 20;
constexpr size_t WS_MOD = 0;
constexpr size_t WS_TAB = 1 * MiB;
constexpr size_t WS_CTL = 3 * MiB, CTL_BYTES = 16384;
constexpr size_t WS_WGU1 = 4 * MiB, WS_WGU2 = 16 * MiB;
constexpr size_t WS_WDN1 = 28 * MiB, WS_WDN2 = 34 * MiB;
constexpr size_t WS_WIN = 40 * MiB, WS_WOUT = 45 * MiB;
constexpr size_t WS_H = 48 * MiB;
constexpr size_t WS_HID = 112 * MiB;
constexpr size_t WS_PROJ = WS_HID, WS_VT = WS_HID + 144 * MiB;
constexpr size_t WS_Y = 288 * MiB;
constexpr size_t WS_END = 416 * MiB;

#define GAS __attribute__((address_space(1)))
#define LAS __attribute__((address_space(3)))
typedef unsigned short bf16;
typedef unsigned v4u __attribute__((ext_vector_type(4)));
typedef unsigned v2u __attribute__((ext_vector_type(2)));
typedef float f32x4 __attribute__((ext_vector_type(4)));
typedef float f32x16 __attribute__((ext_vector_type(16)));
typedef short bf16x8 __attribute__((ext_vector_type(8)));
#define LDS_WAIT() asm volatile("s_waitcnt lgkmcnt(0)" ::: "memory")
__device__ __forceinline__ unsigned f2bf(float f) { unsigned u = __builtin_bit_cast(unsigned, f); return (u + 0x7fffu + ((u >> 16) & 1u)) >> 16; }
__device__ __forceinline__ unsigned pk2(float lo, float hi) { return f2bf(lo) | (f2bf(hi) << 16); }
__device__ __forceinline__ float wave_sum(float v) {
#pragma unroll
    for (int o = 1; o < 64; o <<= 1) v += __shfl_xor(v, o);
    return v;
}


typedef GAS unsigned gu32;
#define RLX_AGENT __ATOMIC_RELAXED, __HIP_MEMORY_SCOPE_AGENT
#define XB_TMO      128
#define XB_XCNT(j)  (256  + 64 * (j))
#define XB_XSUB(j)  (1280 + 64 * (j))
#define XB_XGEN(j)  (2304 + 64 * (j))
#define XB_TOP      3328
#define XB_TOPGEN   3392
#define XCD_BAR_WORDS 3456
#define XB_SPIN_CAP (1u << 18)

__device__ __forceinline__ unsigned xb_ld(unsigned* p)              { return __hip_atomic_load(p, __ATOMIC_RELAXED, __HIP_MEMORY_SCOPE_AGENT); }
__device__ __forceinline__ unsigned xb_add(unsigned* p, unsigned v) { return __hip_atomic_fetch_add(p, v, __ATOMIC_RELAXED, __HIP_MEMORY_SCOPE_AGENT); }
__device__ __forceinline__ unsigned xb_xcc_id() { return (unsigned)__builtin_amdgcn_s_getreg((3 << 11) | 20) & 0xFu; }
#define XB_SPIN(cond, bar) do { unsigned _sp = 0; while (cond) { __builtin_amdgcn_s_sleep(1); \
    if ((++_sp & 255u) == 0u) { if (xb_ld(&(bar)[XB_TMO])) break; if (_sp > XB_SPIN_CAP) { atomicAdd(&(bar)[XB_TMO], 1u); break; } } } } while (0)

struct XcdBarrier {
    unsigned* bar; unsigned x;
    volatile LAS unsigned* st;
};

__device__ __forceinline__ XcdBarrier xcd_barrier_post(unsigned* bar, volatile LAS unsigned* st) {
    XcdBarrier b; b.bar = bar; b.x = xb_xcc_id(); b.st = st;
    if (threadIdx.x == 0) (void)xb_add(&bar[XB_XCNT(b.x)], 1u);
    return b;
}
__device__ __forceinline__ void xcd_barrier_complete(unsigned* bar, unsigned x, unsigned& nloc, unsigned& nx) {
    const unsigned G = gridDim.x * gridDim.y * gridDim.z;
    unsigned sum, cnt, mine, sp = 0u;
    for (;;) {
        sum = 0u; cnt = 0u; mine = 0u;
#pragma unroll
        for (unsigned j = 0; j < 16; ++j) { const unsigned c = xb_ld(&bar[XB_XCNT(j)]); sum += c; cnt += (c > 0u) ? 1u : 0u; mine = (j == x) ? c : mine; }
        if (sum == G) break;
        __builtin_amdgcn_s_sleep(1);
        if ((++sp & 255u) == 0u) { if (xb_ld(&bar[XB_TMO])) break; if (sp > XB_SPIN_CAP) { atomicAdd(&bar[XB_TMO], 1u); break; } }
    }
    nloc = mine > 0u ? mine : 1u; nx = cnt > 0u ? cnt : 1u;
}

__device__ __forceinline__ void xcd_barrier(const XcdBarrier& b) {
    asm volatile("s_waitcnt vmcnt(0)" ::: "memory");
    __syncthreads();
    if (threadIdx.x == 0) {
        unsigned* bar = b.bar;
        __builtin_amdgcn_s_waitcnt(0);
        unsigned nloc = b.st[0], nx = b.st[1];
        if (nloc == 0u) { xcd_barrier_complete(bar, b.x, nloc, nx); b.st[0] = nloc; b.st[1] = nx; }
        const unsigned old = xb_add(&bar[XB_XSUB(b.x)], 1u);
        const unsigned gen = old / nloc;
        if (old + 1u == (gen + 1u) * nloc) {
            __builtin_amdgcn_fence(__ATOMIC_RELEASE, "agent");
            asm volatile("s_waitcnt vmcnt(0)" ::: "memory");
            const unsigned og = xb_add(&bar[XB_TOP], 1u);
            const unsigned tg = og / nx;
            if (og + 1u == (tg + 1u) * nx) xb_add(&bar[XB_TOPGEN], 1u);
            else XB_SPIN(xb_ld(&bar[XB_TOPGEN]) == tg, bar);
            __builtin_amdgcn_fence(__ATOMIC_ACQUIRE, "agent");
            xb_add(&bar[XB_XGEN(b.x)], 1u);
            asm volatile("s_waitcnt vmcnt(0)" ::: "memory");
        } else {
            XB_SPIN(xb_ld(&bar[XB_XGEN(b.x)]) == gen, bar);
            __builtin_amdgcn_fence(__ATOMIC_ACQUIRE, "agent");
            asm volatile("s_waitcnt vmcnt(0)" ::: "memory");
        }
    }
    __syncthreads();
}

constexpr int RING_BYTES = 131072;
constexpr int LDS_BYTES = 135168;

struct Args {
    const float* x; const float* c; const int* pos; const float* w_ada; const float* b_ada;
    const float* gu1; const float* dn1; const float* ln1g; const float* ln1b;
    const float* w_in; const float* conv_w; const float* sinks; const float* w_out; const float* ln2g; const float* ln2b;
    const float* gu2; const float* dn2; const float* ln3g; const float* ln3b;
    float* out; unsigned char* ws; int ph_lo, ph_hi;
};

__device__ __forceinline__ void transpose_item(const float* W, int K, int N, bf16* WT, int k0, int n0, int out_row, LAS float* scr, int lane) {
#pragma unroll 8
    for (int i = 0; i < 32; ++i) { const int kk = 2 * i + (lane >> 5); scr[kk * 33 + (lane & 31)] = W[(size_t)(k0 + kk) * N + n0 + (lane & 31)]; }
    LDS_WAIT(); asm volatile("" ::: "memory");
    const int c = lane & 7;
#pragma unroll
    for (int j = 0; j < 4; ++j) { const int n = (lane >> 3) + 8 * j; const LAS float* s = scr + (8 * c) * 33 + n;
        v4u o; o.x = pk2(s[0 * 33], s[1 * 33]); o.y = pk2(s[2 * 33], s[3 * 33]); o.z = pk2(s[4 * 33], s[5 * 33]); o.w = pk2(s[6 * 33], s[7 * 33]);
        *(v4u*)(WT + (size_t)(out_row + n) * K + k0 + 8 * c) = o; }
    LDS_WAIT(); asm volatile("" ::: "memory");
}
__device__ __forceinline__ void tr_plain(const float* W, int K, int N, bf16* WT, int item, LAS float* scr, int lane) {
    const int nblk = N / 32, kb = item / nblk, nb = item % nblk;
    transpose_item(W, K, N, WT, 64 * kb, 32 * nb, 32 * nb, scr, lane);
}
__device__ __forceinline__ void tr_gu(const float* W, bf16* WT, int item, LAS float* scr, int lane) {
    const int nblk = NGU / 32, kb = item / nblk, nb = item % nblk; const int n0 = 32 * nb;
    const int up = (n0 >= FF) ? 1 : 0; const int j = n0 - up * FF;
    transpose_item(W, D, NGU, WT, 64 * kb, n0, 256 * (j >> 7) + 128 * up + (j & 127), scr, lane);
}

__device__ __forceinline__ void phase0(const Args& a, LAS unsigned char* lds, int tid, int lane, int wave) {
    float* mod = (float*)(a.ws + WS_MOD);
    if ((int)blockIdx.x < 144) {
        LAS float* sc = (LAS float*)lds;
        LAS float* red = (LAS float*)(lds + 65536);
        for (int i = tid; i < 16 * 1024; i += 512) { const float v = a.c[i]; sc[i] = v / (1.0f + __expf(-v)); }
        __syncthreads();
        for (int item = blockIdx.x; item < 144; item += gridDim.x) {
            const int n = 64 * item + lane; const int k0 = 128 * wave;
            float acc[16];
#pragma unroll
            for (int b = 0; b < 16; ++b) acc[b] = 0.f;
            const float* wp = a.w_ada + (size_t)k0 * NMOD + n;
#pragma unroll 4
            for (int k4 = 0; k4 < 128; k4 += 4) {
                const float w0 = wp[(size_t)(k4 + 0) * NMOD], w1 = wp[(size_t)(k4 + 1) * NMOD], w2 = wp[(size_t)(k4 + 2) * NMOD], w3 = wp[(size_t)(k4 + 3) * NMOD];
#pragma unroll
                for (int b = 0; b < 16; ++b) { const f32x4 s = *(const LAS f32x4*)(sc + b * 1024 + k0 + k4); acc[b] += (s.x * w0 + s.y * w1) + (s.z * w2 + s.w * w3); }
            }
#pragma unroll
            for (int b = 0; b < 16; ++b) red[(wave * 16 + b) * 64 + lane] = acc[b];
            __syncthreads();
            for (int o = tid; o < 1024; o += 512) { const int b = o >> 6, cidx = o & 63; float s = 0.f;
#pragma unroll
                for (int w = 0; w < 8; ++w) s += red[(w * 16 + b) * 64 + cidx];
                mod[(size_t)b * NMOD + 64 * item + cidx] = s + a.b_ada[64 * item + cidx]; }
            __syncthreads();
        }
    }
    __syncthreads();
    {
        LAS float* scr = (LAS float*)(lds + wave * 16384);
        const int gw = blockIdx.x * NWAVES + wave, NGW = gridDim.x * NWAVES;
        constexpr int I_GU = (D / 64) * (NGU / 32), I_DN = (FF / 64) * (D / 32), I_IN = (D / 64) * (NIN / 32), I_OUT = (D / 64) * (D / 32);
        constexpr int NITEMS = 2 * I_GU + 2 * I_DN + I_IN + I_OUT;
        for (int it = gw; it < NITEMS; it += NGW) {
            int r = it;
            if (r < I_GU) { tr_gu(a.gu1, (bf16*)(a.ws + WS_WGU1), r, scr, lane); continue; } r -= I_GU;
            if (r < I_GU) { tr_gu(a.gu2, (bf16*)(a.ws + WS_WGU2), r, scr, lane); continue; } r -= I_GU;
            if (r < I_DN) { tr_plain(a.dn1, FF, D, (bf16*)(a.ws + WS_WDN1), r, scr, lane); continue; } r -= I_DN;
            if (r < I_DN) { tr_plain(a.dn2, FF, D, (bf16*)(a.ws + WS_WDN2), r, scr, lane); continue; } r -= I_DN;
            if (r < I_IN) { tr_plain(a.w_in, D, NIN, (bf16*)(a.ws + WS_WIN), r, scr, lane); continue; } r -= I_IN;
            tr_plain(a.w_out, D, D, (bf16*)(a.ws + WS_WOUT), r, scr, lane);
        }
    }
    {
        float* tab = (float*)(a.ws + WS_TAB);
        const int gt = blockIdx.x * 512 + tid, NGT = gridDim.x * 512;
        for (int e = gt; e < M * 8; e += NGT) {
            const int tok = e >> 3, i = e & 7;
            const float invf = (i == 0) ? 1.0f : (i == 1) ? 1.939227432e-01f : (i == 2) ? 3.760603070e-02f : (i == 3) ? 7.292664610e-03f
                             : (i == 4) ? 1.414213562e-03f : (i == 5) ? 2.742481884e-04f : (i == 6) ? 5.318295734e-05f : 1.031338525e-05f;
            const float ang = (float)a.pos[tok] * invf;
            double rev = (double)ang * 0.15915494309189535; rev -= __builtin_rint(rev);
            const float f = (float)rev;
            tab[(size_t)tok * 16 + i] = __builtin_amdgcn_cosf(f);
            tab[(size_t)tok * 16 + 8 + i] = __builtin_amdgcn_sinf(f);
        }
    }
}

__device__ __forceinline__ void phase_mod(const float* x, const float* modsh, const float* modsc, bf16* h, int lane, int wave) {
    const int gw = blockIdx.x * NWAVES + wave, NGW = gridDim.x * NWAVES;
    for (int row = gw; row < M; row += NGW) {
        const int b = row >> 11;
        const f32x4* xr = (const f32x4*)(x + (size_t)row * D) + lane;
        const f32x4* shp = (const f32x4*)(modsh + (size_t)b * NMOD) + lane;
        const f32x4* scp = (const f32x4*)(modsc + (size_t)b * NMOD) + lane;
        v2u* o8 = (v2u*)(h + (size_t)row * D) + lane;
#pragma unroll
        for (int j = 0; j < 4; ++j) {
            const f32x4 v = xr[64 * j], sh = shp[64 * j], sc = scp[64 * j];
            const f32x4 r = v * (sc + 1.0f) + sh;
            v2u w; w.x = pk2(r.x, r.y); w.y = pk2(r.z, r.w); o8[64 * j] = w;
        }
    }
}

__device__ __forceinline__ void phase_ln(const float* y, const float* g, const float* bb, float* xo, const float* modsh, const float* modsc, bf16* h, int lane, int wave) {
    const int gw = blockIdx.x * NWAVES + wave, NGW = gridDim.x * NWAVES;
    f32x4 gv[4], bv[4];
#pragma unroll
    for (int j = 0; j < 4; ++j) { gv[j] = ((const f32x4*)g)[lane + 64 * j]; bv[j] = ((const f32x4*)bb)[lane + 64 * j]; }
    for (int row = gw; row < M; row += NGW) {
        const int b = row >> 11;
        const f32x4* yr = (const f32x4*)(y + (size_t)row * D) + lane;
        f32x4 v[4]; float s = 0.f;
#pragma unroll
        for (int j = 0; j < 4; ++j) { v[j] = yr[64 * j]; s += (v[j].x + v[j].y) + (v[j].z + v[j].w); }
        const float mean = wave_sum(s) * (1.f / D); float s2 = 0.f;
#pragma unroll
        for (int j = 0; j < 4; ++j) { v[j] = v[j] - mean; s2 += (v[j].x * v[j].x + v[j].y * v[j].y) + (v[j].z * v[j].z + v[j].w * v[j].w); }
        const float rstd = 1.f / sqrtf(wave_sum(s2) * (1.f / D) + LN_EPS);
        f32x4* xr = (f32x4*)(xo + (size_t)row * D) + lane;
#pragma unroll
        for (int j = 0; j < 4; ++j) { v[j] = v[j] * rstd * gv[j] + bv[j]; xr[64 * j] = v[j]; }
        if (h) {
            const f32x4* shp = (const f32x4*)(modsh + (size_t)b * NMOD) + lane;
            const f32x4* scp = (const f32x4*)(modsc + (size_t)b * NMOD) + lane;
            v2u* o8 = (v2u*)(h + (size_t)row * D) + lane;
#pragma unroll
            for (int j = 0; j < 4; ++j) { const f32x4 r = v[j] * (scp[64 * j] + 1.0f) + shp[64 * j]; v2u w; w.x = pk2(r.x, r.y); w.y = pk2(r.z, r.w); o8[64 * j] = w; }
        }
    }
}

__device__ __forceinline__ void attn_item(const bf16* P, const bf16* Vt, bf16* cat, float sink, int b, int kvh, int g, int qblk, int lane) {
    const int r32 = lane & 31, hi = lane >> 5;
    const int t0 = qblk * 32; const int hq = kvh * 4 + g;
    const size_t tokbase = (size_t)b * SEQ;
    const float SC = 0.125f * 1.4426950408889634f;
    bf16x8 qf[4];
    { const bf16* qp = P + (tokbase + t0 + r32) * NIN + hq * 64 + 8 * hi;
#pragma unroll
      for (int d0 = 0; d0 < 4; ++d0) qf[d0] = *(const bf16x8*)(qp + 16 * d0); }
    float m_run = sink * 1.4426950408889634f;
    float l_run = (hi == 0) ? 1.0f : 0.0f;
    f32x16 o0, o1;
#pragma unroll
    for (int r = 0; r < 16; ++r) { o0[r] = 0.f; o1[r] = 0.f; }
    const int keyperm = 16 * ((r32 >> 2) & 1) + (r32 & 3) + 4 * (r32 >> 3);
    const bf16* kbase = P + 512 + kvh * 64 + 8 * hi;
    const bf16* vbase = Vt + ((size_t)(b * 2 + kvh) * 64 + r32) * SEQ + 16 * hi;
    const int qp_ = t0 + r32;
    for (int tt = 0; tt < 5; ++tt) {
        const int kb = t0 - 128 + 32 * tt;
        if (kb < 0) continue;
        bf16x8 kf[4], vf[2][2];
        { const bf16* kp = kbase + (tokbase + kb + keyperm) * NIN;
#pragma unroll
          for (int d0 = 0; d0 < 4; ++d0) kf[d0] = *(const bf16x8*)(kp + 16 * d0); }
#pragma unroll
        for (int s = 0; s < 2; ++s)
#pragma unroll
            for (int dh = 0; dh < 2; ++dh) vf[s][dh] = *(const bf16x8*)(vbase + (size_t)dh * 32 * SEQ + kb + 8 * s);
        f32x16 sacc;
#pragma unroll
        for (int r = 0; r < 16; ++r) sacc[r] = 0.f;
#pragma unroll
        for (int d0 = 0; d0 < 4; ++d0) sacc = __builtin_amdgcn_mfma_f32_32x32x16_bf16(kf[d0], qf[d0], sacc, 0, 0, 0);
        float mx = -INFINITY;
#pragma unroll
        for (int r = 0; r < 16; ++r) { const int diff = qp_ - (kb + 16 * hi + r); const bool ok = (diff >= 0) && (diff < 128); sacc[r] = ok ? sacc[r] * SC : -INFINITY; mx = fmaxf(mx, sacc[r]); }
        mx = fmaxf(mx, __shfl_xor(mx, 32));
        const float m_new = fmaxf(m_run, mx);
        const float al = __builtin_amdgcn_exp2f(m_run - m_new);
        m_run = m_new;
        float ps = 0.f;
#pragma unroll
        for (int r = 0; r < 16; ++r) { sacc[r] = __builtin_amdgcn_exp2f(sacc[r] - m_new); ps += sacc[r]; }
        l_run = l_run * al + ps;
#pragma unroll
        for (int r = 0; r < 16; ++r) { o0[r] *= al; o1[r] *= al; }
        v4u pw0, pw1;
        pw0.x = pg8::cvt_pk_bf16(sacc[0], sacc[1]); pw0.y = pg8::cvt_pk_bf16(sacc[2], sacc[3]); pw0.z = pg8::cvt_pk_bf16(sacc[4], sacc[5]); pw0.w = pg8::cvt_pk_bf16(sacc[6], sacc[7]);
        pw1.x = pg8::cvt_pk_bf16(sacc[8], sacc[9]); pw1.y = pg8::cvt_pk_bf16(sacc[10], sacc[11]); pw1.z = pg8::cvt_pk_bf16(sacc[12], sacc[13]); pw1.w = pg8::cvt_pk_bf16(sacc[14], sacc[15]);
        const bf16x8 pb0 = __builtin_bit_cast(bf16x8, pw0), pb1 = __builtin_bit_cast(bf16x8, pw1);
        o0 = __builtin_amdgcn_mfma_f32_32x32x16_bf16(vf[0][0], pb0, o0, 0, 0, 0);
        o1 = __builtin_amdgcn_mfma_f32_32x32x16_bf16(vf[0][1], pb0, o1, 0, 0, 0);
        o0 = __builtin_amdgcn_mfma_f32_32x32x16_bf16(vf[1][0], pb1, o0, 0, 0, 0);
        o1 = __builtin_amdgcn_mfma_f32_32x32x16_bf16(vf[1][1], pb1, o1, 0, 0, 0);
    }
    const float lt = l_run + __shfl_xor(l_run, 32);
    const float inv = 1.0f / lt;
    bf16* op = cat + (tokbase + t0 + r32) * D + hq * 64 + 4 * hi;
#pragma unroll
    for (int q4 = 0; q4 < 4; ++q4) {
        v2u w0, w1;
        w0.x = pg8::cvt_pk_bf16(o0[4 * q4 + 0] * inv, o0[4 * q4 + 1] * inv); w0.y = pg8::cvt_pk_bf16(o0[4 * q4 + 2] * inv, o0[4 * q4 + 3] * inv);
        w1.x = pg8::cvt_pk_bf16(o1[4 * q4 + 0] * inv, o1[4 * q4 + 1] * inv); w1.y = pg8::cvt_pk_bf16(o1[4 * q4 + 2] * inv, o1[4 * q4 + 3] * inv);
        *(v2u*)(op + 8 * q4) = w0; *(v2u*)(op + 32 + 8 * q4) = w1;
    }
}

__device__ __forceinline__ float bf_lo(unsigned w) { return __builtin_bit_cast(float, w << 16); }
__device__ __forceinline__ float bf_hi(unsigned w) { return __builtin_bit_cast(float, w & 0xffff0000u); }

__device__ __forceinline__ void conv_item(const bf16* P, const float* cw, bf16* cat, int item, int lane) {
    const int tokb = item * 16; const int ch = 8 * lane;
    float w0[8], w1[8], w2[8];
#pragma unroll
    for (int j = 0; j < 8; ++j) { w0[j] = cw[ch + j]; w1[j] = cw[512 + ch + j]; w2[j] = cw[1024 + ch + j]; }
    float z1[8], z2[8];
#pragma unroll
    for (int j = 0; j < 8; ++j) { z1[j] = 0.f; z2[j] = 0.f; }
    const int s0 = tokb & (SEQ - 1);
    for (int t = -2; t < 16; ++t) {
        if (s0 + t < 0) continue;
        const bf16* rp = P + (size_t)(tokb + t) * NIN + 768 + ch;
        const v4u uu = *(const v4u*)(rp), cc = *(const v4u*)(rp + 1024);
        float z[8];
        z[0] = bf_lo(uu.x) * bf_lo(cc.x); z[1] = bf_hi(uu.x) * bf_hi(cc.x); z[2] = bf_lo(uu.y) * bf_lo(cc.y); z[3] = bf_hi(uu.y) * bf_hi(cc.y);
        z[4] = bf_lo(uu.z) * bf_lo(cc.z); z[5] = bf_hi(uu.z) * bf_hi(cc.z); z[6] = bf_lo(uu.w) * bf_lo(cc.w); z[7] = bf_hi(uu.w) * bf_hi(cc.w);
        if (t >= 0) {
            const v4u bg = *(const v4u*)(rp + 512);
            float y[8];
#pragma unroll
            for (int j = 0; j < 8; ++j) y[j] = w0[j] * z2[j] + w1[j] * z1[j] + w2[j] * z[j];
            v4u o;
            o.x = pg8::cvt_pk_bf16(bf_lo(bg.x) * y[0], bf_hi(bg.x) * y[1]); o.y = pg8::cvt_pk_bf16(bf_lo(bg.y) * y[2], bf_hi(bg.y) * y[3]);
            o.z = pg8::cvt_pk_bf16(bf_lo(bg.z) * y[4], bf_hi(bg.z) * y[5]); o.w = pg8::cvt_pk_bf16(bf_lo(bg.w) * y[6], bf_hi(bg.w) * y[7]);
            *(v4u*)(cat + (size_t)(tokb + t) * D + 512 + ch) = o;
        }
#pragma unroll
        for (int j = 0; j < 8; ++j) { z2[j] = z1[j]; z1[j] = z[j]; }
    }
}

__device__ __forceinline__ void phase_mixer(const Args& a, int lane, int wave) {
    const bf16* P = (const bf16*)(a.ws + WS_PROJ); const bf16* Vt = (const bf16*)(a.ws + WS_VT); bf16* cat = (bf16*)(a.ws + WS_H);
    for (int it = blockIdx.x; it < BATCH * 2 * (SEQ / 64); it += gridDim.x) {
        const int qb64 = it & 31, kvh = (it >> 5) & 1, b = it >> 6;
        const int g = wave & 3, sub = wave >> 2;
        attn_item(P, Vt, cat, a.sinks[kvh * 4 + g], b, kvh, g, qb64 * 2 + sub, lane);
    }
    const int gw = blockIdx.x * NWAVES + wave, NGW = gridDim.x * NWAVES;
    for (int it = gw; it < M / 16; it += NGW) conv_item(P, a.conv_w, cat, it, lane);
}

constexpr int N_PHASES = 12;
__global__ void __launch_bounds__(NWAVES * 64, 2) mega_fwd(Args a) {
    extern __shared__ __attribute__((aligned(16))) unsigned char lds_raw[];
    LAS unsigned char* lds = (LAS unsigned char*)lds_raw;
    const int tid = threadIdx.x, lane = tid & 63, wave = __builtin_amdgcn_readfirstlane(tid >> 6);
    const int lo = a.ph_lo, hi = a.ph_hi;
    unsigned char* ws = a.ws;
    float* mod = (float*)(ws + WS_MOD);
    bf16* H = (bf16*)(ws + WS_H); bf16* HID = (bf16*)(ws + WS_HID); float* Y = (float*)(ws + WS_Y);
#define IN(k) (lo <= (k) && (k) < hi)
#if MK_SPLIT
#define SEAM(k) do {} while (0)
#else
    if (a.ph_hi > 1000) cg::this_grid().sync();
    if (tid < 64) ((LAS unsigned*)(lds + RING_BYTES))[tid] = 0u;
    __syncthreads();
    XcdBarrier bar = xcd_barrier_post((unsigned*)(ws + WS_CTL), (volatile LAS unsigned*)(lds + RING_BYTES));
#define SEAM(k) do { if (IN(k) && IN((k) + 1)) { xcd_barrier(bar); } } while (0)
#endif
    if (IN(0)) { phase0(a, lds, tid, lane, wave); }
    SEAM(0);
    if (IN(1)) { phase_mod(a.x, mod + 0 * D, mod + 1 * D, H, lane, wave); }
    SEAM(1);
    if (IN(2)) {
        pg8::Gemm g{H, (const bf16*)(ws + WS_WGU1), M, NGU, D}; pg8::StaticOrder S; S.init(M, NGU, gridDim.x, (int)blockIdx.x);
        pg8::EpiSwiGLU E{HID};
        pg8::gemm_phase<pg8::EpiSwiGLU, pg8::StaticOrder, true, true>(lds, g, S, E);
    }
    SEAM(2);
    if (IN(3)) {
        pg8::Gemm g{HID, (const bf16*)(ws + WS_WDN1), M, D, FF}; pg8::StaticOrder S; S.init(M, D, gridDim.x, (int)blockIdx.x);
        pg8::EpiResid E{a.x, Y, mod + 2 * D, 0.5f, DN_ALPHA};
        pg8::gemm_phase<pg8::EpiResid, pg8::StaticOrder, true, true>(lds, g, S, E);
    }
    SEAM(3);
    if (IN(4)) { phase_ln(Y, a.ln1g, a.ln1b, a.out, mod + 3 * D, mod + 4 * D, H, lane, wave); }
    SEAM(4);
    if (IN(5)) {
        pg8::Gemm g{H, (const bf16*)(ws + WS_WIN), M, NIN, D}; pg8::StaticOrder S; S.init(M, NIN, gridDim.x, (int)blockIdx.x);
        pg8::EpiProj E{(bf16*)(ws + WS_PROJ), (bf16*)(ws + WS_VT), (const float*)(ws + WS_TAB)};
        pg8::gemm_phase<pg8::EpiProj, pg8::StaticOrder, true, true>(lds, g, S, E);
    }
    SEAM(5);
    if (IN(6)) { phase_mixer(a, lane, wave); }
    SEAM(6);
    if (IN(7)) {
        pg8::Gemm g{H, (const bf16*)(ws + WS_WOUT), M, D, D}; pg8::StaticOrder S; S.init(M, D, gridDim.x, (int)blockIdx.x);
        pg8::EpiResid E{a.out, Y, mod + 5 * D, 1.0f, DN_ALPHA};
        pg8::gemm_phase<pg8::EpiResid, pg8::StaticOrder, true, true>(lds, g, S, E);
    }
    SEAM(7);
    if (IN(8)) { phase_ln(Y, a.ln2g, a.ln2b, a.out, mod + 6 * D, mod + 7 * D, H, lane, wave); }
    SEAM(8);
    if (IN(9)) {
        pg8::Gemm g{H, (const bf16*)(ws + WS_WGU2), M, NGU, D}; pg8::StaticOrder S; S.init(M, NGU, gridDim.x, (int)blockIdx.x);
        pg8::EpiSwiGLU E{HID};
        pg8::gemm_phase<pg8::EpiSwiGLU, pg8::StaticOrder, true, true>(lds, g, S, E);
    }
    SEAM(9);
    if (IN(10)) {
        pg8::Gemm g{HID, (const bf16*)(ws + WS_WDN2), M, D, FF}; pg8::StaticOrder S; S.init(M, D, gridDim.x, (int)blockIdx.x);
        pg8::EpiResid E{a.out, Y, mod + 8 * D, 0.5f, DN_ALPHA};
        pg8::gemm_phase<pg8::EpiResid, pg8::StaticOrder, true, true>(lds, g, S, E);
    }
    SEAM(10);
    if (IN(11)) { phase_ln(Y, a.ln3g, a.ln3b, a.out, nullptr, nullptr, nullptr, lane, wave); }
#undef IN
#undef SEAM
}

extern "C" void kernel_launch(void* const* d_in, const int* in_sizes, int n_in, void* d_out, int out_size, void* d_ws, size_t ws_size, hipStream_t stream) {
    static int grid = 0;
    if (grid == 0) {
        if (n_in != 19 || in_sizes[0] != M * D || out_size != M * D || ws_size < WS_END) { fprintf(stderr, "kernel_launch: unexpected shapes (n_in %d, in0 %d, out %d, ws %zu); nothing launched\n", n_in, n_in > 0 ? in_sizes[0] : -1, out_size, ws_size); grid = -1; return; }
        int dev = 0, cus = 0, per_cu = 0;
        if (hipGetDevice(&dev) != hipSuccess || hipDeviceGetAttribute(&cus, hipDeviceAttributeMultiprocessorCount, dev) != hipSuccess) { grid = -1; return; }
        if (hipFuncSetAttribute((const void*)mega_fwd, hipFuncAttributeMaxDynamicSharedMemorySize, LDS_BYTES) != hipSuccess) { fprintf(stderr, "kernel_launch: hipFuncSetAttribute failed\n"); grid = -1; return; }
        if (hipOccupancyMaxActiveBlocksPerMultiprocessor(&per_cu, (const void*)mega_fwd, NWAVES * 64, LDS_BYTES) != hipSuccess || per_cu < 1) { fprintf(stderr, "kernel_launch: occupancy query says %d\n", per_cu); per_cu = 1; }
        (void)hipGetLastError();
        grid = cus * per_cu;
    }
    if (grid < 0) return;
    Args a{};
    a.x = (const float*)d_in[0]; a.c = (const float*)d_in[1]; a.pos = (const int*)d_in[2]; a.w_ada = (const float*)d_in[3]; a.b_ada = (const float*)d_in[4];
    a.gu1 = (const float*)d_in[5]; a.dn1 = (const float*)d_in[6]; a.ln1g = (const float*)d_in[7]; a.ln1b = (const float*)d_in[8];
    a.w_in = (const float*)d_in[9]; a.conv_w = (const float*)d_in[10]; a.sinks = (const float*)d_in[11]; a.w_out = (const float*)d_in[12]; a.ln2g = (const float*)d_in[13]; a.ln2b = (const float*)d_in[14];
    a.gu2 = (const float*)d_in[15]; a.dn2 = (const float*)d_in[16]; a.ln3g = (const float*)d_in[17]; a.ln3b = (const float*)d_in[18];
    a.out = (float*)d_out; a.ws = (unsigned char*)d_ws;
#if MK_SPLIT
    for (int p = 0; p < N_PHASES; ++p) {
        a.ph_lo = p; a.ph_hi = p + 1;
        hipLaunchKernelGGL(mega_fwd, dim3(grid), dim3(NWAVES * 64), LDS_BYTES, stream, a);
    }
#else
    a.ph_lo = 0; a.ph_hi = N_PHASES;
    if (hipMemsetAsync((char*)d_ws + WS_CTL, 0, CTL_BYTES, stream) != hipSuccess) { fprintf(stderr, "kernel_launch: memset failed\n"); return; }
    void* kargs[] = {&a};
    hipError_t e = hipLaunchCooperativeKernel((const void*)mega_fwd, dim3(grid), dim3(NWAVES * 64), kargs, LDS_BYTES, stream);
    if (e != hipSuccess) fprintf(stderr, "kernel_launch: cooperative launch failed: %s (grid %d)\n", hipGetErrorString(e), grid);
#endif
}
```
